# Optimizing an MI355X kernel written in HIP

```python
import math
import jax, jax.numpy as jnp
from jax import lax
import numpy as np

D_MODEL = 2048
BATCH = 8
SEQ = 2048
DEPTH = 2
DEC_BATCH = 128
DEC_SEQ = 4
PAST_LEN = 8192
PAGE_SIZE = 128

N_MIXERS = 4
D_MIX = D_MODEL
D_GROUP = D_MIX // N_MIXERS
POOL_WINDOWS = (2, 4, 8, 16)
POOL_GROUPS = len(POOL_WINDOWS)
POOL_CH = D_GROUP // POOL_GROUPS
POOL_PAD = max(POOL_WINDOWS) - 1
CONV_WIDTH = 3
SWA_WINDOW = 128
SWA_BLOCK = SWA_WINDOW
SWA_HEAD_DIM = 64
SWA_Q_HEADS = D_GROUP // SWA_HEAD_DIM
SWA_KV_HEADS = 2
SWA_GROUP = SWA_Q_HEADS // SWA_KV_HEADS
SWA_KV_DIM = SWA_KV_HEADS * SWA_HEAD_DIM
SWA_SCALE = 1.0 / math.sqrt(SWA_HEAD_DIM)
MEM_TOKENS = 256
MEM_HEADS = 4
MEM_HEAD_DIM = D_GROUP // MEM_HEADS
MEM_SCALE = 1.0 / math.sqrt(MEM_HEAD_DIM)
D_FF = 4 * D_MODEL
RMS_EPS = 1e-6
SPLIT_OFFSETS = (D_GROUP, 2 * D_GROUP, 3 * D_GROUP, 4 * D_GROUP, 5 * D_GROUP,
                 5 * D_GROUP + SWA_KV_DIM, 5 * D_GROUP + 2 * SWA_KV_DIM)
D_IN = 6 * D_GROUP + 2 * SWA_KV_DIM

kernel_name = "hymba_pool_conv_swa_memory_decoder_step"


def rmsnorm(x, g):
    x32 = x.astype(jnp.float32)
    y = x32 * lax.rsqrt(jnp.mean(x32 * x32, axis=-1, keepdims=True) + RMS_EPS)
    return (y * g.astype(jnp.float32)).astype(x.dtype)


def multiscale_pool(u_ext, start_pos, t_new):
    b = u_ext.shape[0]
    cs = jnp.cumsum(u_ext.astype(jnp.float32), axis=1)
    cs = jnp.concatenate([jnp.zeros((b, 1, D_GROUP), jnp.float32), cs], axis=1)
    hi = cs[:, POOL_PAD + 1:]
    pos = start_pos + jnp.arange(t_new)
    outs = []
    for gi, w in enumerate(POOL_WINDOWS):
        sl = slice(gi * POOL_CH, (gi + 1) * POOL_CH)
        lo = cs[:, POOL_PAD + 1 - w:POOL_PAD + 1 - w + t_new, sl]
        cnt = jnp.minimum(pos + 1, w).astype(jnp.float32)
        outs.append((hi[:, :, sl] - lo) / cnt[None, :, None])
    return jnp.concatenate(outs, axis=-1).astype(u_ext.dtype)


def pool_mixer(u, u_prev, start_pos, w_pool, pool_scale):
    b, t, _ = u.shape
    u_ext = jnp.concatenate([u_prev, u], axis=1)
    d = (multiscale_pool(u_ext, start_pos, t) - u).reshape(b, t, POOL_GROUPS, POOL_CH)
    y = jnp.einsum('btgc,gcd->btgd', d, w_pool).reshape(b, t, D_GROUP)
    return y * pool_scale, u_ext[:, -POOL_PAD:]


def conv_mixer(hc, gate_b, gate_c, v_prev, conv_w):
    t = hc.shape[1]
    v_ext = jnp.concatenate([v_prev, gate_c * hc], axis=1)
    conv = conv_w[0] * v_ext[:, 0:t]
    for k in range(1, CONV_WIDTH):
        conv = conv + conv_w[k] * v_ext[:, k:k + t]
    return gate_b * conv, v_ext[:, -(CONV_WIDTH - 1):]


def sink_softmax(scores, mask, sink):
    s = jnp.where(mask, scores, -jnp.inf)
    m = jnp.maximum(jnp.max(s, axis=-1, keepdims=True), sink)
    e = jnp.exp(s - m)
    return e / (jnp.sum(e, axis=-1, keepdims=True) + jnp.exp(sink - m))


def swa_banded(q, k, v, sinks):
    b, t = q.shape[0], q.shape[1]
    nb = t // SWA_BLOCK
    qb = q.reshape(b, nb, SWA_BLOCK, SWA_KV_HEADS, SWA_GROUP, SWA_HEAD_DIM)
    def band(a):
        ap = jnp.concatenate([jnp.zeros_like(a[:, :SWA_BLOCK]), a], axis=1)
        ap = ap.reshape(b, nb + 1, SWA_BLOCK, SWA_KV_HEADS, SWA_HEAD_DIM)
        return jnp.concatenate([ap[:, :-1], ap[:, 1:]], axis=2)
    kb, vb = band(k), band(v)
    i = jnp.arange(SWA_BLOCK)[None, :, None]
    j = jnp.arange(2 * SWA_BLOCK)[None, None, :]
    n = jnp.arange(nb)[:, None, None]
    diff = i + SWA_BLOCK - j
    kpos = (n - 1) * SWA_BLOCK + j
    mask = (diff >= 0) & (diff < SWA_WINDOW) & (kpos >= 0)
    scores = jnp.einsum('bnqhgd,bnkhd->bnhgqk', qb, kb,
                        preferred_element_type=jnp.float32) * SWA_SCALE
    sink = sinks.astype(jnp.float32).reshape(SWA_KV_HEADS, SWA_GROUP)[None, None, :, :, None, None]
    p = sink_softmax(scores, mask[None, :, None, None], sink).astype(v.dtype)
    o = jnp.einsum('bnhgqk,bnkhd->bnqhgd', p, vb)
    return o.reshape(b, t, D_GROUP), k[:, -SWA_WINDOW:], v[:, -SWA_WINDOW:]


def swa_buffered(q, k, v, k_prev, v_prev, sinks):
    b, t = q.shape[0], q.shape[1]
    k_all = jnp.concatenate([k_prev, k], axis=1)
    v_all = jnp.concatenate([v_prev, v], axis=1)
    i = jnp.arange(t)[:, None]
    j = jnp.arange(SWA_WINDOW + t)[None, :]
    diff = i + SWA_WINDOW - j
    mask = (diff >= 0) & (diff < SWA_WINDOW)
    scores = jnp.einsum('bqhgd,bkhd->bhgqk', q, k_all,
                        preferred_element_type=jnp.float32) * SWA_SCALE
    sink = sinks.astype(jnp.float32).reshape(SWA_KV_HEADS, SWA_GROUP)[None, :, :, None, None]
    p = sink_softmax(scores, mask[None, None, None], sink).astype(v.dtype)
    o = jnp.einsum('bhgqk,bkhd->bqhgd', p, v_all)
    return o.reshape(b, t, D_GROUP), k_all[:, t:], v_all[:, t:]


def memory_kv(mem, g_mem, w_mem_kv):
    b, m, _ = mem.shape
    kv = rmsnorm(mem, g_mem) @ w_mem_kv
    k, v = jnp.split(kv, 2, axis=-1)
    return (k.reshape(b, m, MEM_HEADS, MEM_HEAD_DIM), v.reshape(b, m, MEM_HEADS, MEM_HEAD_DIM))


def memory_attention(q, mem_k, mem_v):
    b, t = q.shape[0], q.shape[1]
    s = jnp.einsum('bqhd,bkhd->bhqk', q, mem_k, preferred_element_type=jnp.float32) * MEM_SCALE
    p = jax.nn.softmax(s, axis=-1).astype(mem_v.dtype)
    return jnp.einsum('bhqk,bkhd->bqhd', p, mem_v).reshape(b, t, D_GROUP)


def trunk_layer(x, start_pos, pool_prev, conv_prev, swa_k_prev, swa_v_prev, mem_k, mem_v,
                g_mix_pre, w_in, w_pool, pool_scale, conv_w, swa_sinks, w_out, g_mix_post,
                g_mlp_pre, w_up, w_down, g_mlp_post):
    b, t, _ = x.shape
    h = rmsnorm(x, g_mix_pre)
    proj = h @ w_in
    u, hc, gb, gc, q, k, v, qm = jnp.split(proj, SPLIT_OFFSETS, axis=-1)
    y_pool, new_pool = pool_mixer(u, pool_prev, start_pos, w_pool, pool_scale)
    y_conv, new_conv = conv_mixer(hc, gb, gc, conv_prev, conv_w)
    q = q.reshape(b, t, SWA_KV_HEADS, SWA_GROUP, SWA_HEAD_DIM)
    k = k.reshape(b, t, SWA_KV_HEADS, SWA_HEAD_DIM)
    v = v.reshape(b, t, SWA_KV_HEADS, SWA_HEAD_DIM)
    if swa_k_prev is None:
        y_swa, new_k, new_v = swa_banded(q, k, v, swa_sinks)
    else:
        y_swa, new_k, new_v = swa_buffered(q, k, v, swa_k_prev, swa_v_prev, swa_sinks)
    y_mem = memory_attention(qm.reshape(b, t, MEM_HEADS, MEM_HEAD_DIM), mem_k, mem_v)
    mix = jnp.concatenate([y_pool, y_conv, y_swa, y_mem], axis=-1) @ w_out
    x = x + rmsnorm(mix, g_mix_post)
    h2 = rmsnorm(x, g_mlp_pre)
    ff = jnp.square(jax.nn.relu(h2 @ w_up)) @ w_down
    x = x + rmsnorm(ff, g_mlp_post)
    return x, new_pool, new_conv, new_k, new_v


def setup_inputs(seed: int = 0) -> dict:
    key = jax.random.key(seed)
    ks = jax.random.split(key, 24)
    f32 = jnp.float32
    def nrm(k, shape, scale=1.0):
        return jax.random.normal(k, shape, f32) * scale
    def gain(k, shape):
        return 1.0 + 0.05 * jax.random.normal(k, shape, f32)
    return {
        "x_prompt": nrm(ks[0], (BATCH, SEQ, D_MODEL)),
        "x_sample": nrm(ks[1], (DEC_BATCH, DEC_SEQ, D_MODEL)),
        "mem_prompt": nrm(ks[2], (BATCH, MEM_TOKENS, D_MODEL)),
        "state_pool": nrm(ks[3], (DEPTH, DEC_BATCH, POOL_PAD, D_GROUP)),
        "state_conv": nrm(ks[4], (DEPTH, DEC_BATCH, CONV_WIDTH - 1, D_GROUP)),
        "cache_swa_k": nrm(ks[5], (DEPTH, DEC_BATCH, SWA_WINDOW, SWA_KV_HEADS, SWA_HEAD_DIM)),
        "cache_swa_v": nrm(ks[6], (DEPTH, DEC_BATCH, SWA_WINDOW, SWA_KV_HEADS, SWA_HEAD_DIM)),
        "cache_mem_k": nrm(ks[7], (DEPTH, DEC_BATCH, MEM_TOKENS, MEM_HEADS, MEM_HEAD_DIM)),
        "cache_mem_v": nrm(ks[8], (DEPTH, DEC_BATCH, MEM_TOKENS, MEM_HEADS, MEM_HEAD_DIM)),
        "g_mix_pre": gain(ks[9], (DEPTH, D_MODEL)),
        "w_in": nrm(ks[10], (DEPTH, D_MODEL, D_IN), D_MODEL ** -0.5),
        "w_pool": nrm(ks[11], (DEPTH, POOL_GROUPS, POOL_CH, POOL_CH), POOL_CH ** -0.5),
        "pool_scale": gain(ks[12], (DEPTH, D_GROUP)),
        "conv_w": nrm(ks[13], (DEPTH, CONV_WIDTH, D_GROUP), CONV_WIDTH ** -0.5),
        "swa_sinks": nrm(ks[14], (DEPTH, SWA_Q_HEADS), 0.5),
        "g_mem": gain(ks[15], (DEPTH, D_MODEL)),
        "w_mem_kv": nrm(ks[16], (DEPTH, D_MODEL, 2 * D_GROUP), D_MODEL ** -0.5),
        "w_out": nrm(ks[17], (DEPTH, D_MIX, D_MODEL), D_MIX ** -0.5),
        "g_mix_post": gain(ks[18], (DEPTH, D_MODEL)),
        "g_mlp_pre": gain(ks[19], (DEPTH, D_MODEL)),
        "w_up": nrm(ks[20], (DEPTH, D_MODEL, D_FF), D_MODEL ** -0.5),
        "w_down": nrm(ks[21], (DEPTH, D_FF, D_MODEL), D_FF ** -0.5),
        "g_mlp_post": gain(ks[22], (DEPTH, D_MODEL)),
    }


def reference(x_prompt, x_sample, mem_prompt, state_pool, state_conv, cache_swa_k, cache_swa_v,
              cache_mem_k, cache_mem_v, g_mix_pre, w_in, w_pool, pool_scale, conv_w, swa_sinks,
              g_mem, w_mem_kv, w_out, g_mix_post, g_mlp_pre, w_up, w_down, g_mlp_post):
    yp, ys = x_prompt, x_sample
    bp = x_prompt.shape[0]
    pool_p, pool_s, conv_p, conv_s = [], [], [], []
    kp_l, ks_l, vp_l, vs_l, mk_l, mv_l = [], [], [], [], [], []
    for l in range(DEPTH):
        weights = (g_mix_pre[l], w_in[l], w_pool[l], pool_scale[l], conv_w[l], swa_sinks[l],
                   w_out[l], g_mix_post[l], g_mlp_pre[l], w_up[l], w_down[l], g_mlp_post[l])
        mk, mv = memory_kv(mem_prompt, g_mem[l], w_mem_kv[l])
        yp, pp, cp, kp, vp = trunk_layer(
            yp, 0,
            jnp.zeros((bp, POOL_PAD, D_GROUP), x_prompt.dtype),
            jnp.zeros((bp, CONV_WIDTH - 1, D_GROUP), x_prompt.dtype),
            None, None, mk, mv, *weights)
        ys, ps, cs, kss, vss = trunk_layer(
            ys, PAST_LEN, state_pool[l], state_conv[l], cache_swa_k[l], cache_swa_v[l],
            cache_mem_k[l], cache_mem_v[l], *weights)
        pool_p.append(pp); pool_s.append(ps); conv_p.append(cp); conv_s.append(cs)
        kp_l.append(kp); ks_l.append(kss); vp_l.append(vp); vs_l.append(vss)
        mk_l.append(mk); mv_l.append(mv)
    return (yp, ys,
            jnp.stack(pool_p), jnp.stack(pool_s),
            jnp.stack(conv_p), jnp.stack(conv_s),
            jnp.stack(kp_l), jnp.stack(ks_l),
            jnp.stack(vp_l), jnp.stack(vs_l),
            jnp.stack(mk_l), jnp.stack(mv_l))
```

```cpp
#include <hip/hip_runtime.h>
#include <hip/hip_cooperative_groups.h>
#include <cstdio>
#include <cstdint>
#include <cmath>
namespace cg = cooperative_groups;
namespace pg8 {
#define PG8_LAS __attribute__((address_space(3)))
typedef unsigned short bf16_t;
typedef short bf16x8 __attribute__((ext_vector_type(8)));
typedef float f32x4 __attribute__((ext_vector_type(4)));
typedef unsigned u32x4 __attribute__((ext_vector_type(4)));
constexpr int BM = 256, BK = 64, HALF = 128, HTB = HALF * BK * 2  , STAGE_BYTES = 8 * HTB, NXCD = 8, WGM = 8;

__host__ __device__ __forceinline__ int lds_byte(int r, int c) { const int st = (r >> 4) * 2 + (c >> 5), rr = r & 15, cc = c & 31, ob = rr * 64 + cc * 2; return st * 1024 + (ob ^ (((ob >> 9) & 1) << 5)); }
__host__ __device__ __forceinline__ void stage_rc(int b, int& R, int& C) { const int st = b / 1024, sb = b % 1024, swz = sb ^ (((sb >> 9) & 1) << 5); R = (st >> 1) * 16 + swz / 64; C = (st & 1) * 32 + (swz % 64) / 2; }
__host__ __device__ __forceinline__ int perm32(int rho) { const int n = rho >> 4, i = rho & 15; return 8 * (i >> 2) + 4 * n + (i & 3); }

struct Unit { int pm, pn; };
struct Gemm { const bf16_t* A; const bf16_t* Bt; int M, N, K; };

struct StaticOrder {
    int nM, nN, nwg, G, c;
    __host__ __device__ void init(int M, int N, int G_, int c_) { nM = M / BM; nN = N / BM; nwg = nM * nN; G = G_; c = c_; }
    __host__ __device__ bool next(int i, Unit& u) const {
        const long L = (long)i * G + c; if (L >= nwg) return false;
        int wgid = (int)L; { const int q = nwg / NXCD, r = nwg % NXCD, xcd = wgid % NXCD, off = wgid / NXCD; wgid = (xcd < r ? xcd * (q + 1) : r * (q + 1) + (xcd - r) * q) + off; }
        const int nig = WGM * nN, gid = wgid / nig, fm = gid * WGM, gsz = (nM - fm) < WGM ? (nM - fm) : WGM;
        u.pm = fm + ((wgid % nig) % gsz); u.pn = (wgid % nig) / gsz; return true;
    }
    __device__ __forceinline__ void a_ready(const Unit&) const {}
    __device__ __forceinline__ void done(const Unit&) const {}
};
__device__ __forceinline__ unsigned cvt_pk_bf16(float lo, float hi) { unsigned r; asm volatile("v_cvt_pk_bf16_f32 %0, %1, %2" : "=v"(r) : "v"(lo), "v"(hi)); return r; }
typedef float f32x2 __attribute__((ext_vector_type(2)));
typedef float f32x2p __attribute__((ext_vector_type(2))); typedef __bf16 bf16x2p __attribute__((ext_vector_type(2)));
__device__ __forceinline__ unsigned pkbf(float lo, float hi) { f32x2p v = {lo, hi}; bf16x2p b = __builtin_convertvector(v, bf16x2p); return __builtin_bit_cast(unsigned, b); }
__device__ __forceinline__ float bflo(unsigned w) { return __builtin_bit_cast(float, w << 16); }
__device__ __forceinline__ float bfhi(unsigned w) { return __builtin_bit_cast(float, w & 0xffff0000u); }
template <int MODE> struct EpiRowScale {
    static constexpr bool PERM = true, AFTER_DRAIN = false;
    bf16_t* O; int ldc; const float* rs;
    __device__ __forceinline__ void operator()(const f32x4 (&acc)[2][2][4][2], const Unit& u, int wr, int wc, int fr, int fq) const {
        const int row0 = u.pm * BM + wr * 64 + fr, col0 = u.pn * BM + wc * 32 + 8 * fq;
#pragma unroll
        for (int ai = 0; ai < 2; ++ai)
#pragma unroll
            for (int m = 0; m < 4; ++m) { const int row = row0 + ai * HALF + m * 16; const float sc = rs[row]; bf16_t* rowp = O + (size_t)row * ldc + col0;
#pragma unroll
                for (int bj = 0; bj < 2; ++bj) { f32x4 v0 = acc[ai][bj][m][0] * sc, v1 = acc[ai][bj][m][1] * sc;
                    if (MODE == 1) {
#pragma unroll
                        for (int e = 0; e < 4; ++e) { float a = v0[e] > 0.f ? v0[e] : 0.f, b = v1[e] > 0.f ? v1[e] : 0.f; v0[e] = a * a; v1[e] = b * b; } }
                    u32x4 w; w.x = pkbf(v0[0], v0[1]); w.y = pkbf(v0[2], v0[3]); w.z = pkbf(v1[0], v1[1]); w.w = pkbf(v1[2], v1[3]);
                    *(u32x4*)(rowp + bj * HALF) = w; } }
    }
};
struct EpiSumsq {
    static constexpr bool PERM = true, AFTER_DRAIN = false;
    bf16_t* O; int ldc; float* ss;
    __device__ __forceinline__ void operator()(const f32x4 (&acc)[2][2][4][2], const Unit& u, int wr, int wc, int fr, int fq) const {
        const int row0 = u.pm * BM + wr * 64 + fr, col0 = u.pn * BM + wc * 32 + 8 * fq;
#pragma unroll
        for (int ai = 0; ai < 2; ++ai)
#pragma unroll
            for (int m = 0; m < 4; ++m) { const int row = row0 + ai * HALF + m * 16; bf16_t* rowp = O + (size_t)row * ldc + col0; float q = 0.f;
#pragma unroll
                for (int bj = 0; bj < 2; ++bj) { const f32x4 v0 = acc[ai][bj][m][0], v1 = acc[ai][bj][m][1];
                    u32x4 w; w.x = pkbf(v0[0], v0[1]); w.y = pkbf(v0[2], v0[3]); w.z = pkbf(v1[0], v1[1]); w.w = pkbf(v1[2], v1[3]);
                    *(u32x4*)(rowp + bj * HALF) = w;
                    float a;
                    a = bflo(w.x); q += a * a; a = bfhi(w.x); q += a * a; a = bflo(w.y); q += a * a; a = bfhi(w.y); q += a * a;
                    a = bflo(w.z); q += a * a; a = bfhi(w.z); q += a * a; a = bflo(w.w); q += a * a; a = bfhi(w.w); q += a * a; }
                q += __shfl_xor(q, 16); q += __shfl_xor(q, 32);
                if (fq == 0) unsafeAtomicAdd(ss + row, q); }
    }
};
struct EpiMemKV {
    static constexpr bool PERM = true, AFTER_DRAIN = false;
    bf16_t* O; float* OK; float* OV; const float* rs;
    __device__ __forceinline__ void operator()(const f32x4 (&acc)[2][2][4][2], const Unit& u, int wr, int wc, int fr, int fq) const {
        const int row0 = u.pm * BM + wr * 64 + fr, col0 = u.pn * BM + wc * 32 + 8 * fq;
        float* fo = (col0 < 512) ? OK : OV; const int fc0 = col0 & 511;
#pragma unroll
        for (int ai = 0; ai < 2; ++ai)
#pragma unroll
            for (int m = 0; m < 4; ++m) { const int row = row0 + ai * HALF + m * 16; const float sc = rs[row]; bf16_t* rowp = O + (size_t)row * 1024 + col0; float* frow = fo + (size_t)row * 512 + fc0;
#pragma unroll
                for (int bj = 0; bj < 2; ++bj) { const f32x4 v0 = acc[ai][bj][m][0] * sc, v1 = acc[ai][bj][m][1] * sc;
                    u32x4 w; w.x = pkbf(v0[0], v0[1]); w.y = pkbf(v0[2], v0[3]); w.z = pkbf(v1[0], v1[1]); w.w = pkbf(v1[2], v1[3]);
                    *(u32x4*)(rowp + bj * HALF) = w;
                    *(f32x4*)(frow + bj * HALF) = v0; *(f32x4*)(frow + bj * HALF + 4) = v1; } }
    }
};
template <class Epi, class Sched, bool ALIGN_EPI = false, bool SP2 = false>
__device__ __forceinline__ void gemm_phase(PG8_LAS unsigned char* lds, const Gemm g, const Sched& S, const Epi& E) {
    int tid_ = threadIdx.x; asm volatile("" : "+v"(tid_));
    const int tid = tid_, wid = __builtin_amdgcn_readfirstlane(tid >> 6), lane = tid & 63, wr = wid >> 2, wc = wid & 3, fr = lane & 15, fq = lane >> 4;
    const int K = g.K, nt = K / BK;
    unsigned voffA[2], voffB[2];
#pragma unroll
    for (int i = 0; i < 2; ++i) { int R, C; stage_rc(tid * 16 + i * 8192, R, C); const int Rb = Epi::PERM ? ((R & ~31) + perm32(R & 31)) : R;
        voffA[i] = (unsigned)(R * K + C) * 2u; voffB[i] = (unsigned)(Rb * K + C) * 2u; }
    const size_t kstep = (size_t)(BK * 2);
    const size_t hstep = (size_t)HALF * K * 2;
    const size_t tstep = 2 * hstep;
    const unsigned ldsw = (unsigned)wid * 1024u;
    const int aoff = lds_byte(wr * 64 + fr, fq * 8), boff = lds_byte(wc * 32 + fr, fq * 8);
#define PG8_SA(b, h) (((b) * 2 + (h)) * HTB)
#define PG8_SB(b, h) ((4 + (b) * 2 + (h)) * HTB)
#define PG8_STAGE(bufoff, gbase, voff) do { _Pragma("unroll") for (int _i = 0; _i < 2; ++_i) \
        __builtin_amdgcn_global_load_lds((const unsigned*)((const char*)(gbase) + (voff)[_i]), (PG8_LAS unsigned*)(lds + (bufoff) + ldsw + _i * 8192), 16, 0, 0); } while (0)
#define PG8_LDA(dst, b, h) do { _Pragma("unroll") for (int m = 0; m < 4; ++m) _Pragma("unroll") for (int k = 0; k < 2; ++k) dst[m][k] = *(const PG8_LAS bf16x8*)(lds + PG8_SA(b, h) + aoff + m * 2048 + k * 1024); } while (0)
#define PG8_LDB(dst, b, h) do { _Pragma("unroll") for (int n = 0; n < 2; ++n) _Pragma("unroll") for (int k = 0; k < 2; ++k) dst[n][k] = *(const PG8_LAS bf16x8*)(lds + PG8_SB(b, h) + boff + n * 2048 + k * 1024); } while (0)
#define PG8_MMA(ai, bj, At, Bt) do { __builtin_amdgcn_s_setprio(1); _Pragma("unroll") for (int m = 0; m < 4; ++m) _Pragma("unroll") for (int n = 0; n < 2; ++n) _Pragma("unroll") for (int k = 0; k < 2; ++k) \
        acc[ai][bj][m][n] = __builtin_amdgcn_mfma_f32_16x16x32_bf16(Bt[n][k], At[m][k], acc[ai][bj][m][n], 0, 0, 0); __builtin_amdgcn_s_setprio(0); } while (0)
#define PG8_WAIT_V(n) asm volatile("s_waitcnt vmcnt(" #n ")" ::: "memory")
#define PG8_WAIT_L(n) asm volatile("s_waitcnt lgkmcnt(" #n ")" ::: "memory")
#define PG8_BAR __builtin_amdgcn_s_barrier()
#define PG8_SCHED __builtin_amdgcn_sched_barrier(0)
    Unit cur, nxt; int ui = 0;
    if (!S.next(0, cur)) return;
    f32x4 acc[2][2][4][2];
#pragma unroll
    for (int a = 0; a < 2; ++a)
#pragma unroll
        for (int b = 0; b < 2; ++b)
#pragma unroll
            for (int m = 0; m < 4; ++m)
#pragma unroll
                for (int n = 0; n < 2; ++n) acc[a][b][m][n] = (f32x4){0.f, 0.f, 0.f, 0.f};
    bf16x8 At[4][2], B0[2][2], B1[2][2];
    const char* cA = (const char*)g.A + (size_t)cur.pm * tstep; const char* cB = (const char*)g.Bt + (size_t)cur.pn * tstep;
    S.a_ready(cur);
    if constexpr (SP2) {
        PG8_STAGE(PG8_SB(0, 0), cB, voffB); PG8_STAGE(PG8_SB(0, 1), cB + hstep, voffB); PG8_STAGE(PG8_SA(0, 0), cA, voffA); PG8_STAGE(PG8_SA(0, 1), cA + hstep, voffA);
        if (wr == 1) PG8_BAR;
        PG8_WAIT_V(2); PG8_BAR;
        PG8_STAGE(PG8_SB(1, 0), cB + kstep, voffB); PG8_STAGE(PG8_SA(1, 0), cA + kstep, voffA); PG8_STAGE(PG8_SB(1, 1), cB + hstep + kstep, voffB);
        PG8_WAIT_V(6); PG8_BAR;
    } else {
        PG8_STAGE(PG8_SB(0, 0), cB, voffB); PG8_STAGE(PG8_SA(0, 0), cA, voffA); PG8_STAGE(PG8_SB(0, 1), cB + hstep, voffB); PG8_STAGE(PG8_SA(0, 1), cA + hstep, voffA);
        if (wr == 1) PG8_BAR;
        PG8_WAIT_V(4); PG8_BAR;
        PG8_STAGE(PG8_SB(1, 0), cB + kstep, voffB); PG8_STAGE(PG8_SA(1, 0), cA + kstep, voffA); PG8_STAGE(PG8_SB(1, 1), cB + hstep + kstep, voffB);
        PG8_WAIT_V(6); PG8_BAR;
    }
    for (;;) {
        const bool has_next = S.next(ui + 1, nxt);
        const char* nA = has_next ? (const char*)g.A + (size_t)nxt.pm * tstep : cA; const char* nB = has_next ? (const char*)g.Bt + (size_t)nxt.pn * tstep : cB;
        for (int t = 0; t < nt; t += 2) {
            const bool last = (t == nt - 2);
            const char* a1 = cA + (size_t)(t + 1) * kstep;
            const char* a2 = last ? nA : cA + (size_t)(t + 2) * kstep; const char* b2 = last ? nB : cB + (size_t)(t + 2) * kstep;
            const char* a3 = a2 + kstep; const char* b3 = b2 + kstep;
            if (last && has_next) S.a_ready(nxt);
            if constexpr (SP2) {
            PG8_LDB(B0, 0, 0); PG8_LDB(B1, 0, 1); PG8_SCHED; PG8_LDA(At, 0, 0); PG8_STAGE(PG8_SA(1, 1), a1 + hstep, voffA);
            PG8_WAIT_V(8); PG8_WAIT_L(0); PG8_BAR; PG8_MMA(0, 0, At, B0); PG8_MMA(0, 1, At, B1); PG8_BAR; PG8_SCHED;
            PG8_LDA(At, 0, 1); PG8_STAGE(PG8_SB(0, 0), b2, voffB); PG8_STAGE(PG8_SB(0, 1), b2 + hstep, voffB); PG8_STAGE(PG8_SA(0, 0), a2, voffA);
            PG8_WAIT_V(8); PG8_WAIT_L(0); PG8_BAR; PG8_MMA(1, 0, At, B0); PG8_MMA(1, 1, At, B1); PG8_BAR; PG8_SCHED;
            PG8_LDB(B0, 1, 0); PG8_LDB(B1, 1, 1); PG8_SCHED; PG8_LDA(At, 1, 0); PG8_STAGE(PG8_SA(0, 1), a2 + hstep, voffA);
            PG8_WAIT_V(8); PG8_WAIT_L(0); PG8_BAR; PG8_MMA(0, 0, At, B0); PG8_MMA(0, 1, At, B1); PG8_BAR; PG8_SCHED;
            PG8_LDA(At, 1, 1); PG8_STAGE(PG8_SB(1, 0), b3, voffB); PG8_STAGE(PG8_SB(1, 1), b3 + hstep, voffB); PG8_STAGE(PG8_SA(1, 0), a3, voffA);
            PG8_WAIT_V(8); PG8_WAIT_L(0); PG8_BAR; PG8_MMA(1, 0, At, B0); PG8_MMA(1, 1, At, B1); PG8_BAR; PG8_SCHED;
            } else {
            PG8_LDB(B0, 0, 0); PG8_SCHED; PG8_LDA(At, 0, 0); PG8_STAGE(PG8_SA(1, 1), a1 + hstep, voffA);
            PG8_WAIT_L(8); PG8_BAR; PG8_WAIT_L(0); PG8_MMA(0, 0, At, B0); PG8_BAR; PG8_SCHED;
            PG8_LDB(B1, 0, 1); PG8_STAGE(PG8_SB(0, 0), b2, voffB);
            PG8_BAR; PG8_WAIT_L(0); PG8_MMA(0, 1, At, B1); PG8_BAR;
            PG8_LDA(At, 0, 1); PG8_STAGE(PG8_SA(0, 0), a2, voffA);
            PG8_BAR; PG8_WAIT_L(0); PG8_MMA(1, 0, At, B0); PG8_BAR; PG8_SCHED;
            PG8_STAGE(PG8_SB(0, 1), b2 + hstep, voffB);
            PG8_WAIT_V(6); PG8_BAR; PG8_MMA(1, 1, At, B1); PG8_BAR;
            PG8_LDB(B0, 1, 0); PG8_SCHED; PG8_LDA(At, 1, 0); PG8_STAGE(PG8_SA(0, 1), a2 + hstep, voffA);
            PG8_WAIT_L(8); PG8_BAR; PG8_WAIT_L(0); PG8_MMA(0, 0, At, B0); PG8_BAR; PG8_SCHED;
            PG8_LDB(B1, 1, 1); PG8_STAGE(PG8_SB(1, 0), b3, voffB);
            PG8_BAR; PG8_WAIT_L(0); PG8_MMA(0, 1, At, B1); PG8_BAR;
            PG8_LDA(At, 1, 1); PG8_STAGE(PG8_SA(1, 0), a3, voffA);
            PG8_BAR; PG8_WAIT_L(0); PG8_MMA(1, 0, At, B0); PG8_BAR; PG8_SCHED;
            PG8_STAGE(PG8_SB(1, 1), b3 + hstep, voffB);
            PG8_WAIT_V(6); PG8_BAR; PG8_MMA(1, 1, At, B1); PG8_BAR;
            }
        }
        if constexpr (ALIGN_EPI) { if (wr == 0) PG8_BAR; }
        if constexpr (!Epi::AFTER_DRAIN) { E(acc, cur, wr, wc, fr, fq); S.done(cur); }
        if (!has_next) break;
#pragma unroll
        for (int a = 0; a < 2; ++a)
#pragma unroll
            for (int b = 0; b < 2; ++b)
#pragma unroll
                for (int m = 0; m < 4; ++m)
#pragma unroll
                    for (int n = 0; n < 2; ++n) acc[a][b][m][n] = (f32x4){0.f, 0.f, 0.f, 0.f};
        cur = nxt; cA = nA; cB = nB; ++ui;
        if constexpr (ALIGN_EPI) { if (wr == 1) PG8_BAR; }
    }
    PG8_WAIT_V(0);
    if constexpr (!ALIGN_EPI) { if (wr == 0) PG8_BAR; }
    PG8_BAR;
    if constexpr (Epi::AFTER_DRAIN) { E.fused(acc, cur, wr, wc, fr, fq, lds, wid, lane); S.done(cur); }
#undef PG8_SA
#undef PG8_SB
#undef PG8_STAGE
#undef PG8_LDA
#undef PG8_LDB
#undef PG8_MMA
#undef PG8_WAIT_V
#undef PG8_WAIT_L
#undef PG8_BAR
#undef PG8_SCHED
}
}

#define LAS __attribute__((address_space(3)))
typedef unsigned short bf16;
typedef short bf16x8 __attribute__((ext_vector_type(8)));
typedef float f32x4 __attribute__((ext_vector_type(4)));
typedef float f32x16 __attribute__((ext_vector_type(16)));
typedef unsigned v4u __attribute__((ext_vector_type(4)));
typedef unsigned v2u __attribute__((ext_vector_type(2)));
using pg8::pkbf; using pg8::bflo; using pg8::bfhi;

constexpr int NWAVES = 8;
constexpr int DM = 2048, NB = 8, SEQ = 2048, DEPTH = 2, DBT = 128, DSQ = 4;
constexpr int MP = NB * SEQ, MS = DBT * DSQ, M = MP + MS;
constexpr int DG = 512, DIN = 3328, DFF = 8192, MEMT = 256, MEMROWS = NB * MEMT;
constexpr int C_U = 0, C_HC = 512, C_GB = 1024, C_GC = 1536, C_Q = 2048, C_K = 2560, C_V = 2688, C_QM = 2816;
constexpr int MC_POOL = 0, MC_CONV = 512, MC_SWA = 1024, MC_MEM = 1536;
constexpr float RMS_EPS = 1e-6f, LOG2E = 1.4426950408889634f;
constexpr size_t O_Y = 0;
constexpr size_t O_POOL_P = (size_t)M * DM;
constexpr size_t O_POOL_S = O_POOL_P + (size_t)DEPTH * NB * 15 * DG;
constexpr size_t O_CONV_P = O_POOL_S + (size_t)DEPTH * DBT * 15 * DG;
constexpr size_t O_CONV_S = O_CONV_P + (size_t)DEPTH * NB * 2 * DG;
constexpr size_t O_K_P = O_CONV_S + (size_t)DEPTH * DBT * 2 * DG;
constexpr size_t O_K_S = O_K_P + (size_t)DEPTH * NB * 128 * 128;
constexpr size_t O_V_P = O_K_S + (size_t)DEPTH * DBT * 128 * 128;
constexpr size_t O_V_S = O_V_P + (size_t)DEPTH * NB * 128 * 128;
constexpr size_t O_MK = O_V_S + (size_t)DEPTH * DBT * 128 * 128;
constexpr size_t O_MV = O_MK + (size_t)DEPTH * MEMROWS * DG;
constexpr size_t O_END = O_MV + (size_t)DEPTH * MEMROWS * DG;
static_assert(O_END == 50077696, "d_out size");
constexpr size_t MiB = 1u << 20;
constexpr size_t WS_F32 = 1 * MiB;
constexpr size_t WS_W = 8 * MiB;
constexpr size_t W_IN = 0, W_OUT = W_IN + (size_t)DIN * DM * 2, W_UP = W_OUT + (size_t)DM * DM * 2, W_DN = W_UP + (size_t)DFF * DM * 2, W_MKV = W_DN + (size_t)DM * DFF * 2,
                 W_POOL = W_MKV + (size_t)1024 * DM * 2, W_LAYER = W_POOL + (size_t)4 * 128 * 128 * 2;
static_assert(WS_W + 2 * W_LAYER <= 188 * MiB, "weights");
constexpr size_t WS_XB = 188 * MiB, WS_MIX = 254 * MiB, WS_MEMX = 320 * MiB, WS_MEMKV = 328 * MiB, WS_PROJ = 336 * MiB, WS_MIXCAT = 444 * MiB, WS_HID = 336 * MiB, WS_END = 600 * MiB;
static_assert((size_t)M * DM * 2 <= 66 * MiB && WS_PROJ + (size_t)M * DIN * 2 <= WS_MIXCAT && WS_MIXCAT + (size_t)M * DM * 2 <= WS_END && WS_HID + (size_t)M * DFF * 2 <= WS_END, "ws map");
constexpr int F_RSTDA = 0, F_RSTDB = M, F_RSTDM = 2 * M, F_SSMIX = 2 * M + MEMROWS, F_SSFF = F_SSMIX + 2 * M, F_END = F_SSFF + 2 * M;
static_assert((size_t)F_END * 4 <= 7 * MiB, "f32 arrays");
constexpr int LDS_BYTES = 147456;

struct Args { const float* in[23]; float* out; unsigned char* ws; };
enum { I_XP = 0, I_XS, I_MEMP, I_SPOOL, I_SCONV, I_CK, I_CV, I_CMK, I_CMV, I_GPRE, I_WIN, I_WPOOL, I_PSCALE, I_CONVW, I_SINKS, I_GMEM, I_WMKV, I_WOUT, I_GPOST, I_GMLPPRE, I_WUP, I_WDN, I_GMLPPOST };

struct Frame {
    LAS unsigned char* lds;
    int tid, lane, wave, G;
    Args a;
};
#define F_in a.in
#define F_out a.out
__device__ __forceinline__ bf16* XB_(const Frame& F) { return (bf16*)(F.a.ws + WS_XB); }
__device__ __forceinline__ bf16* MIXCAT_(const Frame& F) { return (bf16*)(F.a.ws + WS_MIXCAT); }
__device__ __forceinline__ bf16* MIX_(const Frame& F) { return (bf16*)(F.a.ws + WS_MIX); }
__device__ __forceinline__ bf16* MEMX_(const Frame& F) { return (bf16*)(F.a.ws + WS_MEMX); }
__device__ __forceinline__ bf16* MEMKV_(const Frame& F) { return (bf16*)(F.a.ws + WS_MEMKV); }
__device__ __forceinline__ bf16* PROJ_(const Frame& F) { return (bf16*)(F.a.ws + WS_PROJ); }
__device__ __forceinline__ bf16* HID_(const Frame& F) { return (bf16*)(F.a.ws + WS_HID); }
__device__ __forceinline__ float* F32A_(const Frame& F) { return (float*)(F.a.ws + WS_F32); }
__device__ __forceinline__ bf16* wptr(const Frame& F, int l, size_t off) { return (bf16*)(F.a.ws + WS_W + (size_t)l * W_LAYER + off); }
__device__ __forceinline__ float wave_sum(float v) {
#pragma unroll
    for (int o = 1; o < 64; o <<= 1) v += __shfl_xor(v, o);
    return v;
}
#define LDS_WAIT() asm volatile("s_waitcnt lgkmcnt(0)" ::: "memory")

__device__ __forceinline__ void xpose_item(const float* W, int K, int N, bf16* WT, const float* rg, const float* cgn, LAS float* scr, int item, int lane) {
    const int nblk = N / 32, kb = item / nblk, nb = item % nblk, k0 = 64 * kb, n0 = 32 * nb;
    const float cgv = cgn ? cgn[n0 + (lane & 31)] : 1.f;
#pragma unroll 8
    for (int i = 0; i < 32; ++i) { const int kk = 2 * i + (lane >> 5); float v = W[(size_t)(k0 + kk) * N + n0 + (lane & 31)]; const float g = rg ? rg[k0 + kk] : 1.f; scr[kk * 33 + (lane & 31)] = v * g * cgv; }
    LDS_WAIT(); asm volatile("" ::: "memory");
    const int c = lane & 7;
#pragma unroll
    for (int j = 0; j < 4; ++j) { const int n = (lane >> 3) + 8 * j; const LAS float* s = scr + (8 * c) * 33 + n;
        v4u o; o.x = pkbf(s[0 * 33], s[1 * 33]); o.y = pkbf(s[2 * 33], s[3 * 33]); o.z = pkbf(s[4 * 33], s[5 * 33]); o.w = pkbf(s[6 * 33], s[7 * 33]);
        *(v4u*)(WT + (size_t)(n0 + n) * K + k0 + 8 * c) = o; }
    LDS_WAIT(); asm volatile("" ::: "memory");
}
__device__ __forceinline__ void row_to_bf16(const float* xrow, bf16* orow, float* rstd_out, int lane) {
    const f32x4* xr = (const f32x4*)xrow + lane; float s = 0.f; v2u* o8 = (v2u*)orow + lane;
#pragma unroll
    for (int j = 0; j < 8; ++j) { const f32x4 v = xr[64 * j]; s += (v.x * v.x + v.y * v.y) + (v.z * v.z + v.w * v.w); v2u w; w.x = pkbf(v.x, v.y); w.y = pkbf(v.z, v.w); o8[64 * j] = w; }
    s = wave_sum(s);
    if (lane == 0) *rstd_out = 1.0f / sqrtf(s * (1.f / DM) + RMS_EPS);
}
__device__ __forceinline__ void p0_prologue(Frame& F) {
    LAS float* scr = (LAS float*)(F.lds + F.wave * 16384);
    const int gw = blockIdx.x * NWAVES + F.wave, NGW = F.G * NWAVES;
    constexpr int IT_IN = (DM / 64) * (DIN / 32), IT_OUT = (DM / 64) * (DM / 32), IT_UP = (DM / 64) * (DFF / 32), IT_DN = (DFF / 64) * (DM / 32), IT_MKV = (DM / 64) * (1024 / 32), IT_POOL = 4 * 2 * 4;
    constexpr int IT_LAYER = IT_IN + IT_OUT + IT_UP + IT_DN + IT_MKV + IT_POOL;
    for (int it = gw; it < 2 * IT_LAYER; it += NGW) {
        const int l = it / IT_LAYER; int r = it % IT_LAYER;
        if (r < IT_IN) { xpose_item(F.a.in[I_WIN] + (size_t)l * DM * DIN, DM, DIN, wptr(F, l, W_IN), F.a.in[I_GPRE] + l * DM, nullptr, scr, r, F.lane); continue; } r -= IT_IN;
        if (r < IT_OUT) { xpose_item(F.a.in[I_WOUT] + (size_t)l * DM * DM, DM, DM, wptr(F, l, W_OUT), nullptr, nullptr, scr, r, F.lane); continue; } r -= IT_OUT;
        if (r < IT_UP) { xpose_item(F.a.in[I_WUP] + (size_t)l * DM * DFF, DM, DFF, wptr(F, l, W_UP), F.a.in[I_GMLPPRE] + l * DM, nullptr, scr, r, F.lane); continue; } r -= IT_UP;
        if (r < IT_DN) { xpose_item(F.a.in[I_WDN] + (size_t)l * DFF * DM, DFF, DM, wptr(F, l, W_DN), nullptr, nullptr, scr, r, F.lane); continue; } r -= IT_DN;
        if (r < IT_MKV) { xpose_item(F.a.in[I_WMKV] + (size_t)l * DM * 1024, DM, 1024, wptr(F, l, W_MKV), F.a.in[I_GMEM] + l * DM, nullptr, scr, r, F.lane); continue; } r -= IT_MKV;
        { const int g = r / 8, ri = r % 8; xpose_item(F.a.in[I_WPOOL] + (size_t)(l * 4 + g) * 128 * 128, 128, 128, wptr(F, l, W_POOL) + (size_t)g * 128 * 128, nullptr, F.a.in[I_PSCALE] + l * DG + g * 128, scr, ri, F.lane); }
    }
    for (int m = gw; m < M + MEMROWS; m += NGW) {
        if (m < MP) row_to_bf16(F.a.in[I_XP] + (size_t)m * DM, XB_(F) + (size_t)m * DM, F32A_(F) + F_RSTDA + m, F.lane);
        else if (m < M) row_to_bf16(F.a.in[I_XS] + (size_t)(m - MP) * DM, XB_(F) + (size_t)m * DM, F32A_(F) + F_RSTDA + m, F.lane);
        else row_to_bf16(F.a.in[I_MEMP] + (size_t)(m - M) * DM, MEMX_(F) + (size_t)(m - M) * DM, F32A_(F) + F_RSTDM + (m - M), F.lane);
    }
    for (int i = blockIdx.x * 512 + F.tid; i < 4 * M; i += F.G * 512) F32A_(F)[F_SSMIX + i] = 0.f;
}

template <int D, bool MASK>
__device__ __forceinline__ void attn_sub(LAS const unsigned char* Kl, LAS const unsigned char* VTl, const bf16* qrow, bf16* orow, float m0, float l0, int lo, int hi, int t_lo, int t_hi, float scale2, int lane) {
    constexpr int KS = D * 2 + 16, VS = 528;
    const int r = lane & 31, h = lane >> 5;
    bf16x8 qf[D / 16];
#pragma unroll
    for (int d0 = 0; d0 < D / 16; ++d0) { if (qrow) qf[d0] = *(const bf16x8*)(qrow + d0 * 16 + 8 * h); else qf[d0] = (bf16x8){0, 0, 0, 0, 0, 0, 0, 0}; }
    f32x16 o[D / 32];
#pragma unroll
    for (int b = 0; b < D / 32; ++b)
#pragma unroll
        for (int i = 0; i < 16; ++i) o[b][i] = 0.f;
    float m = m0, l = (h == 0) ? l0 : 0.f;
    for (int t = t_lo; t <= t_hi; ++t) {
        f32x16 s;
#pragma unroll
        for (int i = 0; i < 16; ++i) s[i] = 0.f;
        LAS const unsigned char* kp = Kl + (t * 32 + r) * KS + h * 16;
#pragma unroll
        for (int d0 = 0; d0 < D / 16; ++d0) { const bf16x8 kf = *(LAS const bf16x8*)(kp + d0 * 32); s = __builtin_amdgcn_mfma_f32_32x32x16_bf16(kf, qf[d0], s, 0, 0, 0); }
        float mx = -INFINITY;
#pragma unroll
        for (int i = 0; i < 16; ++i) { const int key = t * 32 + (i & 3) + 8 * (i >> 2) + 4 * h; float v = s[i] * scale2; if (MASK) { if (!(key > lo && key <= hi)) v = -INFINITY; } s[i] = v; mx = fmaxf(mx, v); }
        mx = fmaxf(mx, __shfl_xor(mx, 32));
        const float mn = fmaxf(m, mx), alpha = __builtin_amdgcn_exp2f(m - mn);
        m = mn;
        float rs = 0.f;
#pragma unroll
        for (int i = 0; i < 16; ++i) { s[i] = __builtin_amdgcn_exp2f(s[i] - mn); rs += s[i]; }
        l = l * alpha + rs;
#pragma unroll
        for (int b = 0; b < D / 32; ++b)
#pragma unroll
            for (int i = 0; i < 16; ++i) o[b][i] *= alpha;
        v4u p0, p1;
        p0.x = pkbf(s[0], s[1]); p0.y = pkbf(s[2], s[3]); p0.z = pkbf(s[4], s[5]); p0.w = pkbf(s[6], s[7]);
        p1.x = pkbf(s[8], s[9]); p1.y = pkbf(s[10], s[11]); p1.z = pkbf(s[12], s[13]); p1.w = pkbf(s[14], s[15]);
        const bf16x8 pb0 = __builtin_bit_cast(bf16x8, p0), pb1 = __builtin_bit_cast(bf16x8, p1);
#pragma unroll
        for (int b = 0; b < D / 32; ++b) {
            LAS const unsigned char* vp = VTl + (b * 32 + r) * VS + (t * 32 + 4 * h) * 2;
            const v2u a0 = *(LAS const v2u*)(vp), a1 = *(LAS const v2u*)(vp + 16), a2 = *(LAS const v2u*)(vp + 32), a3 = *(LAS const v2u*)(vp + 48);
            const v4u f0 = {a0.x, a0.y, a1.x, a1.y}, f1 = {a2.x, a2.y, a3.x, a3.y};
            o[b] = __builtin_amdgcn_mfma_f32_32x32x16_bf16(__builtin_bit_cast(bf16x8, f0), pb0, o[b], 0, 0, 0);
            o[b] = __builtin_amdgcn_mfma_f32_32x32x16_bf16(__builtin_bit_cast(bf16x8, f1), pb1, o[b], 0, 0, 0);
        }
    }
    l += __shfl_xor(l, 32);
    const float inv = 1.0f / l;
    if (orow) {
#pragma unroll
        for (int b = 0; b < D / 32; ++b)
#pragma unroll
            for (int g4 = 0; g4 < 4; ++g4) { v2u w; w.x = pkbf(o[b][4 * g4] * inv, o[b][4 * g4 + 1] * inv); w.y = pkbf(o[b][4 * g4 + 2] * inv, o[b][4 * g4 + 3] * inv);
                *(v2u*)(orow + b * 32 + 8 * g4 + 4 * h) = w; }
    }
}
template <int D>
__device__ __forceinline__ void put_kv(LAS unsigned char* Kl, LAS unsigned char* VTl, int key, int ch, v4u kv, v4u vv) {
    constexpr int KS = D * 2 + 16, VS = 528;
    *(LAS v4u*)(Kl + key * KS + ch * 16) = kv;
    LAS unsigned char* vp = VTl + (ch * 8) * VS + key * 2;
    *(LAS unsigned short*)(vp + 0 * VS) = (unsigned short)(vv.x & 0xffffu); *(LAS unsigned short*)(vp + 1 * VS) = (unsigned short)(vv.x >> 16);
    *(LAS unsigned short*)(vp + 2 * VS) = (unsigned short)(vv.y & 0xffffu); *(LAS unsigned short*)(vp + 3 * VS) = (unsigned short)(vv.y >> 16);
    *(LAS unsigned short*)(vp + 4 * VS) = (unsigned short)(vv.z & 0xffffu); *(LAS unsigned short*)(vp + 5 * VS) = (unsigned short)(vv.z >> 16);
    *(LAS unsigned short*)(vp + 6 * VS) = (unsigned short)(vv.w & 0xffffu); *(LAS unsigned short*)(vp + 7 * VS) = (unsigned short)(vv.w >> 16);
}
__device__ __forceinline__ v4u cvt8(const float* p) { const f32x4 a = *(const f32x4*)p, b = *(const f32x4*)(p + 4); v4u w; w.x = pkbf(a.x, a.y); w.y = pkbf(a.z, a.w); w.z = pkbf(b.x, b.y); w.w = pkbf(b.z, b.w); return w; }

__device__ __forceinline__ void swa_prompt_unit(Frame& F, int l, int unit) {
    constexpr int D = 64, KS = D * 2 + 16;
    const int b = unit >> 5, kvh = (unit >> 4) & 1, n = unit & 15;
    LAS unsigned char* Kl = F.lds; LAS unsigned char* VTl = F.lds + 256 * KS;
    const int row0 = b * SEQ + (n - 1) * 128;
    for (int c = F.tid; c < 256 * 8; c += 512) { const int key = c >> 3, ch = c & 7; v4u kv = {0u, 0u, 0u, 0u}, vv = {0u, 0u, 0u, 0u};
        if (!(n == 0 && key < 128)) { const bf16* rp = PROJ_(F) + (size_t)(row0 + key) * DIN; kv = *(const v4u*)(rp + C_K + kvh * 64 + ch * 8); vv = *(const v4u*)(rp + C_V + kvh * 64 + ch * 8); }
        put_kv<D>(Kl, VTl, key, ch, kv, vv); }
    __syncthreads();
    const int g = F.wave >> 1, r = F.lane & 31;
    const float sink2 = F.a.in[I_SINKS][l * 8 + kvh * 4 + g] * LOG2E;
    for (int sb = 0; sb < 2; ++sb) {
        const int i0 = (F.wave & 1) * 64 + sb * 32, i = i0 + r; const size_t row = (size_t)b * SEQ + n * 128 + i;
        int t_lo = i0 >> 5; if (n == 0 && t_lo < 4) t_lo = 4;
        const int lo = (n == 0 && i < 127) ? 127 : i;
        attn_sub<D, true>(Kl, VTl, PROJ_(F) + row * DIN + C_Q + kvh * 256 + g * 64, MIXCAT_(F) + row * DM + MC_SWA + kvh * 256 + g * 64, sink2, 1.0f, lo, i + 128, t_lo, (i0 >> 5) + 4, 0.125f * LOG2E, F.lane);
    }
    __syncthreads();
}
__device__ __forceinline__ void swa_sample_unit(Frame& F, int l, int unit) {
    constexpr int D = 64, KS = D * 2 + 16;
    const int b = unit >> 1, kvh = unit & 1;
    LAS unsigned char* Kl = F.lds; LAS unsigned char* VTl = F.lds + 256 * KS;
    for (int c = F.tid; c < 160 * 8; c += 512) { const int key = c >> 3, ch = c & 7; v4u kv = {0u, 0u, 0u, 0u}, vv = {0u, 0u, 0u, 0u};
        if (key < 128) { const size_t ci = ((size_t)(l * DBT + b) * 128 + key) * 128 + kvh * 64 + ch * 8; kv = cvt8(F.a.in[I_CK] + ci); vv = cvt8(F.a.in[I_CV] + ci); }
        else if (key < 132) { const bf16* rp = PROJ_(F) + (size_t)(MP + b * 4 + key - 128) * DIN; kv = *(const v4u*)(rp + C_K + kvh * 64 + ch * 8); vv = *(const v4u*)(rp + C_V + kvh * 64 + ch * 8); }
        put_kv<D>(Kl, VTl, key, ch, kv, vv); }
    __syncthreads();
    if (F.wave == 0) {
        const int r = F.lane & 31, i = (r >> 2) & 3, g = r & 3; const bool valid = r < 16; const size_t row = (size_t)MP + b * 4 + i;
        const float sink2 = F.a.in[I_SINKS][l * 8 + kvh * 4 + g] * LOG2E;
        attn_sub<D, true>(Kl, VTl, valid ? PROJ_(F) + row * DIN + C_Q + kvh * 256 + g * 64 : nullptr, valid ? MIXCAT_(F) + row * DM + MC_SWA + kvh * 256 + g * 64 : nullptr, sink2, 1.0f, i, i + 128, 0, 4, 0.125f * LOG2E, F.lane);
    }
    __syncthreads();
}
__device__ __forceinline__ void mem_prompt_unit(Frame& F, int l, int unit) {
    constexpr int D = 128, KS = D * 2 + 16;
    const int b = unit >> 5, hh = (unit >> 3) & 3, qt = unit & 7;
    LAS unsigned char* Kl = F.lds; LAS unsigned char* VTl = F.lds + 256 * KS;
    const bf16* kvb = MEMKV_(F) + (size_t)l * MEMROWS * 1024 + (size_t)b * MEMT * 1024 + hh * 128;
    for (int c = F.tid; c < 256 * 16; c += 512) { const int key = c >> 4, ch = c & 15; const bf16* rp = kvb + (size_t)key * 1024 + ch * 8;
        put_kv<D>(Kl, VTl, key, ch, *(const v4u*)rp, *(const v4u*)(rp + 512)); }
    __syncthreads();
    { const int r = F.lane & 31; const size_t row = (size_t)b * SEQ + qt * 256 + F.wave * 32 + r;
      attn_sub<D, false>(Kl, VTl, PROJ_(F) + row * DIN + C_QM + hh * 128, MIXCAT_(F) + row * DM + MC_MEM + hh * 128, -1e30f, 0.f, -1, 255, 0, 7, 0.08838834764831845f * LOG2E, F.lane); }
    __syncthreads();
}
__device__ __forceinline__ void mem_sample_unit(Frame& F, int l, int unit) {
    constexpr int D = 128, KS = D * 2 + 16;
    const int b = unit >> 2, hh = unit & 3;
    LAS unsigned char* Kl = F.lds; LAS unsigned char* VTl = F.lds + 256 * KS;
    const size_t cb = ((size_t)(l * DBT + b) * MEMT) * 512 + hh * 128;
    for (int c = F.tid; c < 256 * 16; c += 512) { const int key = c >> 4, ch = c & 15; const size_t ci = cb + (size_t)key * 512 + ch * 8;
        put_kv<D>(Kl, VTl, key, ch, cvt8(F.a.in[I_CMK] + ci), cvt8(F.a.in[I_CMV] + ci)); }
    __syncthreads();
    if (F.wave == 0) { const int r = F.lane & 31; const bool valid = r < 4; const size_t row = (size_t)MP + b * 4 + (r & 3);
      attn_sub<D, false>(Kl, VTl, valid ? PROJ_(F) + row * DIN + C_QM + hh * 128 : nullptr, valid ? MIXCAT_(F) + row * DM + MC_MEM + hh * 128 : nullptr, -1e30f, 0.f, -1, 255, 0, 7, 0.08838834764831845f * LOG2E, F.lane); }
    __syncthreads();
}
__device__ __forceinline__ void poolconv_unit(Frame& F, int l, int unit) {
    const int tok0 = unit * 64;
    {
        const int sub = F.wave >> 2, g = F.wave & 3, W = 2 << g, t0 = tok0 + sub * 32, lane = F.lane;
        LAS unsigned char* dl = F.lds + F.wave * (32 * 272);
        const int c = g * 128 + lane * 2;
        const bool prompt = t0 < MP;
        for (int tt = 0; tt < 32; ++tt) {
            const int row = t0 + tt; float s0 = 0.f, s1 = 0.f, u0, u1, cnt;
            const unsigned uw = *(const unsigned*)(PROJ_(F) + (size_t)row * DIN + C_U + c); u0 = bflo(uw); u1 = bfhi(uw);
            if (prompt) { const int pos = row & (SEQ - 1); const int nw = (pos + 1 < W) ? pos + 1 : W; cnt = (float)nw;
                for (int i = 0; i < nw; ++i) { const unsigned w = *(const unsigned*)(PROJ_(F) + (size_t)(row - i) * DIN + C_U + c); s0 += bflo(w); s1 += bfhi(w); } }
            else { const int sb = (row - MP) >> 2, i4 = (row - MP) & 3; cnt = (float)W;
                for (int i = 0; i < W; ++i) { const int e = 15 + i4 - i;
                    if (e >= 15) { const unsigned w = *(const unsigned*)(PROJ_(F) + (size_t)(MP + sb * 4 + e - 15) * DIN + C_U + c); s0 += bflo(w); s1 += bfhi(w); }
                    else { const float* sp = F.a.in[I_SPOOL] + ((size_t)(l * DBT + sb) * 15 + e) * DG + c; s0 += sp[0]; s1 += sp[1]; } } }
            *(LAS unsigned*)(dl + tt * 272 + lane * 4) = pkbf(s0 / cnt - u0, s1 / cnt - u1);
        }
        LDS_WAIT(); asm volatile("" ::: "memory");
        const int r = lane & 31, h = lane >> 5;
        bf16x8 bfr[8];
#pragma unroll
        for (int ks = 0; ks < 8; ++ks) bfr[ks] = *(LAS const bf16x8*)(dl + r * 272 + (ks * 16 + 8 * h) * 2);
        const bf16* wp = wptr(F, l, W_POOL) + (size_t)g * 128 * 128;
        bf16* orow = MIXCAT_(F) + (size_t)(t0 + r) * DM + MC_POOL + g * 128;
#pragma unroll
        for (int eb = 0; eb < 4; ++eb) {
            f32x16 acc;
#pragma unroll
            for (int i = 0; i < 16; ++i) acc[i] = 0.f;
#pragma unroll
            for (int ks = 0; ks < 8; ++ks) { const bf16x8 af = *(const bf16x8*)(wp + (size_t)(eb * 32 + r) * 128 + ks * 16 + 8 * h); acc = __builtin_amdgcn_mfma_f32_32x32x16_bf16(af, bfr[ks], acc, 0, 0, 0); }
#pragma unroll
            for (int g4 = 0; g4 < 4; ++g4) { v2u w; w.x = pkbf(acc[4 * g4], acc[4 * g4 + 1]); w.y = pkbf(acc[4 * g4 + 2], acc[4 * g4 + 3]); *(v2u*)(orow + eb * 32 + 8 * g4 + 4 * h) = w; }
        }
    }
    {
        const float* cw = F.a.in[I_CONVW] + (size_t)l * 3 * DG;
        for (int it = F.tid; it < 64 * 64; it += 512) {
            const int tt = it >> 6, c = (it & 63) * 8, row = tok0 + tt;
            float v[3][8];
#pragma unroll
            for (int k = 0; k < 3; ++k) {
                const int back = 2 - k; bool zero = false; const float* st = nullptr; int prow = row - back;
                if (row < MP) { if ((row & (SEQ - 1)) < back) zero = true; }
                else { const int sb = (row - MP) >> 2, i4 = (row - MP) & 3, e = 2 + i4 - back; if (e < 2) st = F.a.in[I_SCONV] + ((size_t)(l * DBT + sb) * 2 + e) * DG + c; else prow = MP + sb * 4 + e - 2; }
                if (zero) {
#pragma unroll
                    for (int j = 0; j < 8; ++j) v[k][j] = 0.f; }
                else if (st) { const f32x4 a = *(const f32x4*)st, bq = *(const f32x4*)(st + 4); v[k][0] = a.x; v[k][1] = a.y; v[k][2] = a.z; v[k][3] = a.w; v[k][4] = bq.x; v[k][5] = bq.y; v[k][6] = bq.z; v[k][7] = bq.w; }
                else { const bf16* rp = PROJ_(F) + (size_t)prow * DIN + c; const v4u hcv = *(const v4u*)(rp + C_HC), gcv = *(const v4u*)(rp + C_GC);
                    v[k][0] = bflo(hcv.x) * bflo(gcv.x); v[k][1] = bfhi(hcv.x) * bfhi(gcv.x); v[k][2] = bflo(hcv.y) * bflo(gcv.y); v[k][3] = bfhi(hcv.y) * bfhi(gcv.y);
                    v[k][4] = bflo(hcv.z) * bflo(gcv.z); v[k][5] = bfhi(hcv.z) * bfhi(gcv.z); v[k][6] = bflo(hcv.w) * bflo(gcv.w); v[k][7] = bfhi(hcv.w) * bfhi(gcv.w); }
            }
            const v4u gbv = *(const v4u*)(PROJ_(F) + (size_t)row * DIN + C_GB + c);
            float gb[8] = {bflo(gbv.x), bfhi(gbv.x), bflo(gbv.y), bfhi(gbv.y), bflo(gbv.z), bfhi(gbv.z), bflo(gbv.w), bfhi(gbv.w)};
            float y[8];
#pragma unroll
            for (int j = 0; j < 8; ++j) y[j] = gb[j] * (cw[c + j] * v[0][j] + cw[DG + c + j] * v[1][j] + cw[2 * DG + c + j] * v[2][j]);
            v4u w; w.x = pkbf(y[0], y[1]); w.y = pkbf(y[2], y[3]); w.z = pkbf(y[4], y[5]); w.w = pkbf(y[6], y[7]);
            *(v4u*)(MIXCAT_(F) + (size_t)row * DM + MC_CONV + c) = w;
        }
    }
    __syncthreads();
}
__device__ __forceinline__ f32x4 bf4(const bf16* p) { const v2u w = *(const v2u*)p; return (f32x4){bflo(w.x), bfhi(w.x), bflo(w.y), bfhi(w.y)}; }
__device__ __forceinline__ f32x4 vrow4(const bf16* rp) { return bf4(rp + C_HC) * bf4(rp + C_GC); }
__device__ __forceinline__ void states_phase(Frame& F, int l) {
    const int gt = blockIdx.x * 512 + F.tid, NT = F.G * 512;
    float* out = F.a.out; const bf16* P = PROJ_(F);
    for (int i = gt; i < NB * 15 * 128; i += NT) { const int c = (i & 127) * 4, j = (i >> 7) % 15, b = (i >> 7) / 15;
        *(f32x4*)(out + O_POOL_P + ((size_t)(l * NB + b) * 15 + j) * DG + c) = bf4(P + (size_t)(b * SEQ + SEQ - 15 + j) * DIN + C_U + c); }
    for (int i = gt; i < DBT * 15 * 128; i += NT) { const int c = (i & 127) * 4, j = (i >> 7) % 15, b = (i >> 7) / 15; f32x4 v;
        if (j < 11) v = *(const f32x4*)(F.a.in[I_SPOOL] + ((size_t)(l * DBT + b) * 15 + 4 + j) * DG + c); else v = bf4(P + (size_t)(MP + b * 4 + j - 11) * DIN + C_U + c);
        *(f32x4*)(out + O_POOL_S + ((size_t)(l * DBT + b) * 15 + j) * DG + c) = v; }
    for (int i = gt; i < NB * 2 * 128; i += NT) { const int c = (i & 127) * 4, j = (i >> 7) & 1, b = i >> 8;
        *(f32x4*)(out + O_CONV_P + ((size_t)(l * NB + b) * 2 + j) * DG + c) = vrow4(P + (size_t)(b * SEQ + SEQ - 2 + j) * DIN + c); }
    for (int i = gt; i < DBT * 2 * 128; i += NT) { const int c = (i & 127) * 4, j = (i >> 7) & 1, b = i >> 8;
        *(f32x4*)(out + O_CONV_S + ((size_t)(l * DBT + b) * 2 + j) * DG + c) = vrow4(P + (size_t)(MP + b * 4 + 2 + j) * DIN + c); }
    for (int i = gt; i < NB * 128 * 32; i += NT) { const int c = (i & 31) * 4, j = (i >> 5) & 127, b = i >> 12; const bf16* rp = P + (size_t)(b * SEQ + SEQ - 128 + j) * DIN + c; const size_t o = ((size_t)(l * NB + b) * 128 + j) * 128 + c;
        *(f32x4*)(out + O_K_P + o) = bf4(rp + C_K); *(f32x4*)(out + O_V_P + o) = bf4(rp + C_V); }
    for (int i = gt; i < DBT * 128 * 32; i += NT) { const int c = (i & 31) * 4, j = (i >> 5) & 127, b = i >> 12; const size_t o = ((size_t)(l * DBT + b) * 128 + j) * 128 + c; f32x4 kv, vv;
        if (j < 124) { const size_t ci = ((size_t)(l * DBT + b) * 128 + 4 + j) * 128 + c; kv = *(const f32x4*)(F.a.in[I_CK] + ci); vv = *(const f32x4*)(F.a.in[I_CV] + ci); }
        else { const bf16* rp = P + (size_t)(MP + b * 4 + j - 124) * DIN + c; kv = bf4(rp + C_K); vv = bf4(rp + C_V); }
        *(f32x4*)(out + O_K_S + o) = kv; *(f32x4*)(out + O_V_S + o) = vv; }
}
__device__ __forceinline__ void p2_mixers(Frame& F, int l) {
#ifndef SK_A
    for (int u = blockIdx.x; u < 256; u += F.G) swa_prompt_unit(F, l, u);
#endif
#ifndef SK_B
    for (int u = blockIdx.x; u < 256; u += F.G) mem_prompt_unit(F, l, u);
#endif
#ifndef SK_C
    for (int u = blockIdx.x; u < 256; u += F.G) swa_sample_unit(F, l, u);
#endif
#ifndef SK_D
    for (int u = blockIdx.x; u < 512; u += F.G) mem_sample_unit(F, l, u);
#endif
#ifndef SK_E
    for (int u = blockIdx.x; u < M / 64; u += F.G) poolconv_unit(F, l, u);
#endif
#ifndef SK_F
    states_phase(F, l);
#endif
}

__device__ __forceinline__ void rowwise_phase(Frame& F, bool first, const float* ssarr, const float* gain, float* rstd_out) {
    const int gw = blockIdx.x * NWAVES + F.wave, NGW = F.G * NWAVES, lane = F.lane;
    for (int m = gw; m < M; m += NGW) {
        const float* xr = first ? (m < MP ? F.a.in[I_XP] + (size_t)m * DM : F.a.in[I_XS] + (size_t)(m - MP) * DM) : F.a.out + O_Y + (size_t)m * DM;
        const float rs = 1.0f / sqrtf(ssarr[m] * (1.f / DM) + RMS_EPS);
        const bf16* tr = MIX_(F) + (size_t)m * DM; float* yr = F.a.out + O_Y + (size_t)m * DM; bf16* xb = XB_(F) + (size_t)m * DM;
        f32x4 v[8]; float s = 0.f;
#pragma unroll
        for (int j = 0; j < 8; ++j) { const int c = j * 256 + lane * 4; const f32x4 x = *(const f32x4*)(xr + c), g = *(const f32x4*)(gain + c), t = bf4(tr + c);
            v[j] = x + g * t * rs; s += (v[j].x * v[j].x + v[j].y * v[j].y) + (v[j].z * v[j].z + v[j].w * v[j].w); }
        s = wave_sum(s);
#pragma unroll
        for (int j = 0; j < 8; ++j) { const int c = j * 256 + lane * 4; *(f32x4*)(yr + c) = v[j];
            if (rstd_out) { v2u w; w.x = pkbf(v[j].x, v[j].y); w.y = pkbf(v[j].z, v[j].w); *(v2u*)(xb + c) = w; } }
        if (rstd_out && lane == 0) rstd_out[m] = 1.0f / sqrtf(s * (1.f / DM) + RMS_EPS);
    }
}

#ifndef SK_G
#define GEMM_PHASE(EPI, g, S, E) pg8::gemm_phase<EPI, pg8::StaticOrder, true, true>(F.lds, g, S, E)
#else
#define GEMM_PHASE(EPI, g, S, E) do { (void)g; (void)S; (void)E; } while (0)
#endif
template <int l> __device__ __forceinline__ void layer_body(Frame& F, cg::grid_group& grid) {
    {
        pg8::Gemm g{XB_(F), wptr(F, l, W_IN), M, DIN, DM}; pg8::StaticOrder S; S.init(M, DIN, F.G, (int)blockIdx.x);
        pg8::EpiRowScale<0> E{PROJ_(F), DIN, F32A_(F) + F_RSTDA};
        GEMM_PHASE(pg8::EpiRowScale<0>, g, S, E);
        pg8::Gemm g2{MEMX_(F), wptr(F, l, W_MKV), MEMROWS, 1024, DM}; pg8::StaticOrder S2; S2.init(MEMROWS, 1024, F.G, F.G - 1 - (int)blockIdx.x);
        pg8::EpiMemKV E2{MEMKV_(F) + (size_t)l * MEMROWS * 1024, F.a.out + O_MK + (size_t)l * MEMROWS * DG, F.a.out + O_MV + (size_t)l * MEMROWS * DG, F32A_(F) + F_RSTDM};
        GEMM_PHASE(pg8::EpiMemKV, g2, S2, E2);
    }
    grid.sync();
    p2_mixers(F, l);
    grid.sync();
    {
        pg8::Gemm g{MIXCAT_(F), wptr(F, l, W_OUT), M, DM, DM}; pg8::StaticOrder S; S.init(M, DM, F.G, (int)blockIdx.x);
        pg8::EpiSumsq E{MIX_(F), DM, F32A_(F) + F_SSMIX + l * M};
        GEMM_PHASE(pg8::EpiSumsq, g, S, E);
    }
    grid.sync();
    rowwise_phase(F, l == 0, F32A_(F) + F_SSMIX + l * M, F.a.in[I_GPOST] + l * DM, F32A_(F) + F_RSTDB);
    grid.sync();
    {
        pg8::Gemm g{XB_(F), wptr(F, l, W_UP), M, DFF, DM}; pg8::StaticOrder S; S.init(M, DFF, F.G, (int)blockIdx.x);
        pg8::EpiRowScale<1> E{HID_(F), DFF, F32A_(F) + F_RSTDB};
        GEMM_PHASE(pg8::EpiRowScale<1>, g, S, E);
    }
    grid.sync();
    {
        pg8::Gemm g{HID_(F), wptr(F, l, W_DN), M, DM, DFF}; pg8::StaticOrder S; S.init(M, DM, F.G, (int)blockIdx.x);
        pg8::EpiSumsq E{MIX_(F), DM, F32A_(F) + F_SSFF + l * M};
        GEMM_PHASE(pg8::EpiSumsq, g, S, E);
    }
    grid.sync();
    rowwise_phase(F, false, F32A_(F) + F_SSFF + l * M, F.a.in[I_GMLPPOST] + l * DM, (l + 1 < DEPTH) ? F32A_(F) + F_RSTDA : nullptr);
    if (l + 1 < DEPTH) grid.sync();
}
__global__ void __launch_bounds__(NWAVES * 64, 2) hymba_fwd(Args args) {
    extern __shared__ __attribute__((aligned(16))) unsigned char lds[];
    cg::grid_group grid = cg::this_grid();
    Frame F;
    F.lds = (LAS unsigned char*)lds;
    F.tid = threadIdx.x; F.lane = F.tid & 63; F.wave = __builtin_amdgcn_readfirstlane(F.tid >> 6); F.G = gridDim.x;
    F.a = args;
    p0_prologue(F);
    grid.sync();
    layer_body<0>(F, grid);
    layer_body<1>(F, grid);
}

extern "C" void kernel_launch(void* const* d_in, const int* in_sizes, int n_in, void* d_out, int out_size, void* d_ws, size_t ws_size, hipStream_t stream) {
    static int grid = 0;
    if (grid == 0) {
        if (n_in != 23 || in_sizes[0] != MP * DM || (size_t)out_size != O_END || ws_size < WS_END) { fprintf(stderr, "kernel_launch: unexpected shapes (n_in %d, in0 %d, out %d, ws %zu); nothing launched\n", n_in, n_in > 0 ? in_sizes[0] : -1, out_size, ws_size); grid = -1; return; }
        int dev = 0, cus = 0, per_cu = 0;
        if (hipGetDevice(&dev) != hipSuccess || hipDeviceGetAttribute(&cus, hipDeviceAttributeMultiprocessorCount, dev) != hipSuccess) { grid = -1; return; }
        if (hipFuncSetAttribute((const void*)hymba_fwd, hipFuncAttributeMaxDynamicSharedMemorySize, LDS_BYTES) != hipSuccess) { fprintf(stderr, "kernel_launch: hipFuncSetAttribute failed\n"); grid = -1; return; }
        if (hipOccupancyMaxActiveBlocksPerMultiprocessor(&per_cu, (const void*)hymba_fwd, NWAVES * 64, LDS_BYTES) != hipSuccess || per_cu < 1) { fprintf(stderr, "kernel_launch: occupancy query says %d blocks per CU\n", per_cu); per_cu = 1; }
        (void)hipGetLastError();
        grid = cus * per_cu;
    }
    if (grid < 0) return;
    Args a{};
    for (int i = 0; i < 23; ++i) a.in[i] = (const float*)d_in[i];
    a.out = (float*)d_out; a.ws = (unsigned char*)d_ws;
    void* kargs[] = {&a};
    const hipError_t e = hipLaunchCooperativeKernel((const void*)hymba_fwd, dim3(grid), dim3(NWAVES * 64), kargs, LDS_BYTES, stream);
    if (e != hipSuccess) fprintf(stderr, "kernel_launch: cooperative launch failed: %s (grid %d)\n", hipGetErrorString(e), grid);
}
```

```cpp
#include <hip/hip_runtime.h>
#include <hip/hip_cooperative_groups.h>
#include <cstdio>
#include <cstdint>
#include <cmath>
namespace cg = cooperative_groups;
namespace pg8 {
#define PG8_LAS __attribute__((address_space(3)))
typedef unsigned short bf16_t;
typedef short bf16x8 __attribute__((ext_vector_type(8)));
typedef float f32x4 __attribute__((ext_vector_type(4)));
typedef unsigned u32x4 __attribute__((ext_vector_type(4)));
constexpr int BM = 256, BK = 64, HALF = 128, HTB = HALF * BK * 2  , STAGE_BYTES = 8 * HTB, NXCD = 8, WGM = 8;

__host__ __device__ __forceinline__ int lds_byte(int r, int c) { const int st = (r >> 4) * 2 + (c >> 5), rr = r & 15, cc = c & 31, ob = rr * 64 + cc * 2; return st * 1024 + (ob ^ (((ob >> 9) & 1) << 5)); }
__host__ __device__ __forceinline__ void stage_rc(int b, int& R, int& C) { const int st = b / 1024, sb = b % 1024, swz = sb ^ (((sb >> 9) & 1) << 5); R = (st >> 1) * 16 + swz / 64; C = (st & 1) * 32 + (swz % 64) / 2; }
__host__ __device__ __forceinline__ int perm32(int rho) { const int n = rho >> 4, i = rho & 15; return 8 * (i >> 2) + 4 * n + (i & 3); }

struct Unit { int pm, pn, kofs; };
struct Gemm { const bf16_t* A; const bf16_t* Bt; int M, N, K, lda; };

struct StaticOrder {
    int nM, nN, nwg, G, c;
    __host__ __device__ void init(int M, int N, int G_, int c_) { nM = M / BM; nN = N / BM; nwg = nM * nN; G = G_; c = c_; }
    __host__ __device__ bool next(int i, Unit& u) const {
        const long L = (long)i * G + c; if (L >= nwg) return false;
        int wgid = (int)L; { const int q = nwg / NXCD, r = nwg % NXCD, xcd = wgid % NXCD, off = wgid / NXCD; wgid = (xcd < r ? xcd * (q + 1) : r * (q + 1) + (xcd - r) * q) + off; }
        const int nig = WGM * nN, gid = wgid / nig, fm = gid * WGM, gsz = (nM - fm) < WGM ? (nM - fm) : WGM;
        u.pm = fm + ((wgid % nig) % gsz); u.pn = (wgid % nig) / gsz; u.kofs = 0; return true;
    }
    __device__ __forceinline__ void a_ready(const Unit&) const {}
    __device__ __forceinline__ void done(const Unit&) const {}
};
__device__ __forceinline__ unsigned cvt_pk_bf16(float lo, float hi) { unsigned r; asm volatile("v_cvt_pk_bf16_f32 %0, %1, %2" : "=v"(r) : "v"(lo), "v"(hi)); return r; }
typedef float f32x2 __attribute__((ext_vector_type(2)));
struct SplitOrder {
    int npieces, kpiece, G, c;
    __device__ __forceinline__ bool next(int i, Unit& u) const { const int L = i * G + c; if (L >= npieces) return false; const int su = L & 15, ks = L >> 4; u.pm = 64 + (su >> 3); u.pn = su & 7; u.kofs = ks * kpiece; return true; }
    __device__ __forceinline__ void a_ready(const Unit&) const {}
    __device__ __forceinline__ void done(const Unit&) const {}
};
typedef float f32x2p __attribute__((ext_vector_type(2))); typedef __bf16 bf16x2p __attribute__((ext_vector_type(2)));
__device__ __forceinline__ unsigned pkbf(float lo, float hi) { f32x2p v = {lo, hi}; bf16x2p b = __builtin_convertvector(v, bf16x2p); return __builtin_bit_cast(unsigned, b); }
__device__ __forceinline__ float bflo(unsigned w) { return __builtin_bit_cast(float, w << 16); }
__device__ __forceinline__ float bfhi(unsigned w) { return __builtin_bit_cast(float, w & 0xffff0000u); }
template <int MODE> struct EpiRowScale {
    static constexpr bool PERM = true, AFTER_DRAIN = false;
    bf16_t* O; int ldc; const float* rs;
    __device__ __forceinline__ void operator()(const f32x4 (&acc)[2][2][4][2], const Unit& u, int wr, int wc, int fr, int fq) const {
        const int row0 = u.pm * BM + wr * 64 + fr, col0 = u.pn * BM + wc * 32 + 8 * fq;
#pragma unroll
        for (int ai = 0; ai < 2; ++ai)
#pragma unroll
            for (int m = 0; m < 4; ++m) { const int row = row0 + ai * HALF + m * 16; const float sc = rs[row]; bf16_t* rowp = O + (size_t)row * ldc + col0;
#pragma unroll
                for (int bj = 0; bj < 2; ++bj) { f32x4 v0 = acc[ai][bj][m][0] * sc, v1 = acc[ai][bj][m][1] * sc;
                    if (MODE == 1) {
#pragma unroll
                        for (int e = 0; e < 4; ++e) { float a = v0[e] > 0.f ? v0[e] : 0.f, b = v1[e] > 0.f ? v1[e] : 0.f; v0[e] = a * a; v1[e] = b * b; } }
                    u32x4 w; w.x = pkbf(v0[0], v0[1]); w.y = pkbf(v0[2], v0[3]); w.z = pkbf(v1[0], v1[1]); w.w = pkbf(v1[2], v1[3]);
                    *(u32x4*)(rowp + bj * HALF) = w; } }
    }
};
struct EpiStore {
    static constexpr bool PERM = true, AFTER_DRAIN = false;
    bf16_t* O; int ldc;
    __device__ __forceinline__ void operator()(const f32x4 (&acc)[2][2][4][2], const Unit& u, int wr, int wc, int fr, int fq) const {
        const int row0 = u.pm * BM + wr * 64 + fr, col0 = u.pn * BM + wc * 32 + 8 * fq;
#pragma unroll
        for (int ai = 0; ai < 2; ++ai)
#pragma unroll
            for (int m = 0; m < 4; ++m) { const int row = row0 + ai * HALF + m * 16; bf16_t* rowp = O + (size_t)row * ldc + col0;
#pragma unroll
                for (int bj = 0; bj < 2; ++bj) { const f32x4 v0 = acc[ai][bj][m][0], v1 = acc[ai][bj][m][1];
                    u32x4 w; w.x = pkbf(v0[0], v0[1]); w.y = pkbf(v0[2], v0[3]); w.z = pkbf(v1[0], v1[1]); w.w = pkbf(v1[2], v1[3]);
                    *(u32x4*)(rowp + bj * HALF) = w; } }
    }
};
struct EpiPartF32 {
    static constexpr bool PERM = true, AFTER_DRAIN = false;
    float* P; int kpiece;
    __device__ __forceinline__ void operator()(const f32x4 (&acc)[2][2][4][2], const Unit& u, int wr, int wc, int fr, int fq) const {
        const int row0 = (u.pm - 64) * BM + wr * 64 + fr, col0 = u.pn * BM + wc * 32 + 8 * fq;
        float* base = P + (size_t)(u.kofs / kpiece) * 512 * 2048;
#pragma unroll
        for (int ai = 0; ai < 2; ++ai)
#pragma unroll
            for (int m = 0; m < 4; ++m) { float* rowp = base + (size_t)(row0 + ai * HALF + m * 16) * 2048 + col0;
#pragma unroll
                for (int bj = 0; bj < 2; ++bj) { *(f32x4*)(rowp + bj * HALF) = acc[ai][bj][m][0]; *(f32x4*)(rowp + bj * HALF + 4) = acc[ai][bj][m][1]; } }
    }
};
struct EpiMemKV {
    static constexpr bool PERM = true, AFTER_DRAIN = false;
    bf16_t* O; float* OK; float* OV; const float* rs;
    __device__ __forceinline__ void operator()(const f32x4 (&acc)[2][2][4][2], const Unit& u, int wr, int wc, int fr, int fq) const {
        const int row0 = u.pm * BM + wr * 64 + fr, col0 = u.pn * BM + wc * 32 + 8 * fq;
        float* fo = (col0 < 512) ? OK : OV; const int fc0 = col0 & 511;
#pragma unroll
        for (int ai = 0; ai < 2; ++ai)
#pragma unroll
            for (int m = 0; m < 4; ++m) { const int row = row0 + ai * HALF + m * 16; const float sc = rs[row]; bf16_t* rowp = O + (size_t)row * 1024 + col0; float* frow = fo + (size_t)row * 512 + fc0;
#pragma unroll
                for (int bj = 0; bj < 2; ++bj) { const f32x4 v0 = acc[ai][bj][m][0] * sc, v1 = acc[ai][bj][m][1] * sc;
                    u32x4 w; w.x = pkbf(v0[0], v0[1]); w.y = pkbf(v0[2], v0[3]); w.z = pkbf(v1[0], v1[1]); w.w = pkbf(v1[2], v1[3]);
                    *(u32x4*)(rowp + bj * HALF) = w;
                    *(f32x4*)(frow + bj * HALF) = v0; *(f32x4*)(frow + bj * HALF + 4) = v1; } }
    }
};
template <class Epi, class Sched, bool ALIGN_EPI = false, bool SP2 = false>
__device__ __forceinline__ void gemm_phase(PG8_LAS unsigned char* lds, const Gemm g, const Sched& S, const Epi& E) {
    int tid_ = threadIdx.x; asm volatile("" : "+v"(tid_));
    const int tid = tid_, wid = __builtin_amdgcn_readfirstlane(tid >> 6), lane = tid & 63, wr = wid >> 2, wc = wid & 3, fr = lane & 15, fq = lane >> 4;
    const int K = g.lda, nt = g.K / BK;
    unsigned voffA[2], voffB[2];
#pragma unroll
    for (int i = 0; i < 2; ++i) { int R, C; stage_rc(tid * 16 + i * 8192, R, C); const int Rb = Epi::PERM ? ((R & ~31) + perm32(R & 31)) : R;
        voffA[i] = (unsigned)(R * K + C) * 2u; voffB[i] = (unsigned)(Rb * K + C) * 2u; }
    const size_t kstep = (size_t)(BK * 2);
    const size_t hstep = (size_t)HALF * K * 2;
    const size_t tstep = 2 * hstep;
    const unsigned ldsw = (unsigned)wid * 1024u;
    const int aoff = lds_byte(wr * 64 + fr, fq * 8), boff = lds_byte(wc * 32 + fr, fq * 8);
#define PG8_SA(b, h) (((b) * 2 + (h)) * HTB)
#define PG8_SB(b, h) ((4 + (b) * 2 + (h)) * HTB)
#define PG8_STAGE(bufoff, gbase, voff) do { _Pragma("unroll") for (int _i = 0; _i < 2; ++_i) \
        __builtin_amdgcn_global_load_lds((const unsigned*)((const char*)(gbase) + (voff)[_i]), (PG8_LAS unsigned*)(lds + (bufoff) + ldsw + _i * 8192), 16, 0, 0); } while (0)
#define PG8_LDA(dst, b, h) do { _Pragma("unroll") for (int m = 0; m < 4; ++m) _Pragma("unroll") for (int k = 0; k < 2; ++k) dst[m][k] = *(const PG8_LAS bf16x8*)(lds + PG8_SA(b, h) + aoff + m * 2048 + k * 1024); } while (0)
#define PG8_LDB(dst, b, h) do { _Pragma("unroll") for (int n = 0; n < 2; ++n) _Pragma("unroll") for (int k = 0; k < 2; ++k) dst[n][k] = *(const PG8_LAS bf16x8*)(lds + PG8_SB(b, h) + boff + n * 2048 + k * 1024); } while (0)
#define PG8_MMA(ai, bj, At, Bt) do { __builtin_amdgcn_s_setprio(1); _Pragma("unroll") for (int m = 0; m < 4; ++m) _Pragma("unroll") for (int n = 0; n < 2; ++n) _Pragma("unroll") for (int k = 0; k < 2; ++k) \
        acc[ai][bj][m][n] = __builtin_amdgcn_mfma_f32_16x16x32_bf16(Bt[n][k], At[m][k], acc[ai][bj][m][n], 0, 0, 0); __builtin_amdgcn_s_setprio(0); } while (0)
#define PG8_WAIT_V(n) asm volatile("s_waitcnt vmcnt(" #n ")" ::: "memory")
#define PG8_WAIT_L(n) asm volatile("s_waitcnt lgkmcnt(" #n ")" ::: "memory")
#define PG8_BAR __builtin_amdgcn_s_barrier()
#define PG8_SCHED __builtin_amdgcn_sched_barrier(0)
    Unit cur, nxt; int ui = 0;
    if (!S.next(0, cur)) return;
    f32x4 acc[2][2][4][2];
#pragma unroll
    for (int a = 0; a < 2; ++a)
#pragma unroll
        for (int b = 0; b < 2; ++b)
#pragma unroll
            for (int m = 0; m < 4; ++m)
#pragma unroll
                for (int n = 0; n < 2; ++n) acc[a][b][m][n] = (f32x4){0.f, 0.f, 0.f, 0.f};
    bf16x8 At[4][2], B0[2][2], B1[2][2];
    const char* cA = (const char*)g.A + (size_t)cur.pm * tstep + (size_t)cur.kofs * 2; const char* cB = (const char*)g.Bt + (size_t)cur.pn * tstep + (size_t)cur.kofs * 2;
    S.a_ready(cur);
    if constexpr (SP2) {
        PG8_STAGE(PG8_SB(0, 0), cB, voffB); PG8_STAGE(PG8_SB(0, 1), cB + hstep, voffB); PG8_STAGE(PG8_SA(0, 0), cA, voffA); PG8_STAGE(PG8_SA(0, 1), cA + hstep, voffA);
        if (wr == 1) PG8_BAR;
        PG8_WAIT_V(2); PG8_BAR;
        PG8_STAGE(PG8_SB(1, 0), cB + kstep, voffB); PG8_STAGE(PG8_SA(1, 0), cA + kstep, voffA); PG8_STAGE(PG8_SB(1, 1), cB + hstep + kstep, voffB);
        PG8_WAIT_V(6); PG8_BAR;
    } else {
        PG8_STAGE(PG8_SB(0, 0), cB, voffB); PG8_STAGE(PG8_SA(0, 0), cA, voffA); PG8_STAGE(PG8_SB(0, 1), cB + hstep, voffB); PG8_STAGE(PG8_SA(0, 1), cA + hstep, voffA);
        if (wr == 1) PG8_BAR;
        PG8_WAIT_V(4); PG8_BAR;
        PG8_STAGE(PG8_SB(1, 0), cB + kstep, voffB); PG8_STAGE(PG8_SA(1, 0), cA + kstep, voffA); PG8_STAGE(PG8_SB(1, 1), cB + hstep + kstep, voffB);
        PG8_WAIT_V(6); PG8_BAR;
    }
    for (;;) {
        const bool has_next = S.next(ui + 1, nxt);
        const char* nA = has_next ? (const char*)g.A + (size_t)nxt.pm * tstep + (size_t)nxt.kofs * 2 : cA; const char* nB = has_next ? (const char*)g.Bt + (size_t)nxt.pn * tstep + (size_t)nxt.kofs * 2 : cB;
        for (int t = 0; t < nt; t += 2) {
            const bool last = (t == nt - 2);
            const char* a1 = cA + (size_t)(t + 1) * kstep;
            const char* a2 = last ? nA : cA + (size_t)(t + 2) * kstep; const char* b2 = last ? nB : cB + (size_t)(t + 2) * kstep;
            const char* a3 = a2 + kstep; const char* b3 = b2 + kstep;
            if (last && has_next) S.a_ready(nxt);
            if constexpr (SP2) {
            PG8_LDB(B0, 0, 0); PG8_LDB(B1, 0, 1); PG8_SCHED; PG8_LDA(At, 0, 0); PG8_STAGE(PG8_SA(1, 1), a1 + hstep, voffA);
            PG8_WAIT_V(8); PG8_WAIT_L(0); PG8_BAR; PG8_MMA(0, 0, At, B0); PG8_MMA(0, 1, At, B1); PG8_BAR; PG8_SCHED;
            PG8_LDA(At, 0, 1); PG8_STAGE(PG8_SB(0, 0), b2, voffB); PG8_STAGE(PG8_SB(0, 1), b2 + hstep, voffB); PG8_STAGE(PG8_SA(0, 0), a2, voffA);
            PG8_WAIT_V(8); PG8_WAIT_L(0); PG8_BAR; PG8_MMA(1, 0, At, B0); PG8_MMA(1, 1, At, B1); PG8_BAR; PG8_SCHED;
            PG8_LDB(B0, 1, 0); PG8_LDB(B1, 1, 1); PG8_SCHED; PG8_LDA(At, 1, 0); PG8_STAGE(PG8_SA(0, 1), a2 + hstep, voffA);
            PG8_WAIT_V(8); PG8_WAIT_L(0); PG8_BAR; PG8_MMA(0, 0, At, B0); PG8_MMA(0, 1, At, B1); PG8_BAR; PG8_SCHED;
            PG8_LDA(At, 1, 1); PG8_STAGE(PG8_SB(1, 0), b3, voffB); PG8_STAGE(PG8_SB(1, 1), b3 + hstep, voffB); PG8_STAGE(PG8_SA(1, 0), a3, voffA);
            PG8_WAIT_V(8); PG8_WAIT_L(0); PG8_BAR; PG8_MMA(1, 0, At, B0); PG8_MMA(1, 1, At, B1); PG8_BAR; PG8_SCHED;
            } else {
            PG8_LDB(B0, 0, 0); PG8_SCHED; PG8_LDA(At, 0, 0); PG8_STAGE(PG8_SA(1, 1), a1 + hstep, voffA);
            PG8_WAIT_L(8); PG8_BAR; PG8_WAIT_L(0); PG8_MMA(0, 0, At, B0); PG8_BAR; PG8_SCHED;
            PG8_LDB(B1, 0, 1); PG8_STAGE(PG8_SB(0, 0), b2, voffB);
            PG8_BAR; PG8_WAIT_L(0); PG8_MMA(0, 1, At, B1); PG8_BAR;
            PG8_LDA(At, 0, 1); PG8_STAGE(PG8_SA(0, 0), a2, voffA);
            PG8_BAR; PG8_WAIT_L(0); PG8_MMA(1, 0, At, B0); PG8_BAR; PG8_SCHED;
            PG8_STAGE(PG8_SB(0, 1), b2 + hstep, voffB);
            PG8_WAIT_V(6); PG8_BAR; PG8_MMA(1, 1, At, B1); PG8_BAR;
            PG8_LDB(B0, 1, 0); PG8_SCHED; PG8_LDA(At, 1, 0); PG8_STAGE(PG8_SA(0, 1), a2 + hstep, voffA);
            PG8_WAIT_L(8); PG8_BAR; PG8_WAIT_L(0); PG8_MMA(0, 0, At, B0); PG8_BAR; PG8_SCHED;
            PG8_LDB(B1, 1, 1); PG8_STAGE(PG8_SB(1, 0), b3, voffB);
            PG8_BAR; PG8_WAIT_L(0); PG8_MMA(0, 1, At, B1); PG8_BAR;
            PG8_LDA(At, 1, 1); PG8_STAGE(PG8_SA(1, 0), a3, voffA);
            PG8_BAR; PG8_WAIT_L(0); PG8_MMA(1, 0, At, B0); PG8_BAR; PG8_SCHED;
            PG8_STAGE(PG8_SB(1, 1), b3 + hstep, voffB);
            PG8_WAIT_V(6); PG8_BAR; PG8_MMA(1, 1, At, B1); PG8_BAR;
            }
        }
        if constexpr (ALIGN_EPI) { if (wr == 0) PG8_BAR; }
        if constexpr (!Epi::AFTER_DRAIN) { E(acc, cur, wr, wc, fr, fq); S.done(cur); }
        if (!has_next) break;
#pragma unroll
        for (int a = 0; a < 2; ++a)
#pragma unroll
            for (int b = 0; b < 2; ++b)
#pragma unroll
                for (int m = 0; m < 4; ++m)
#pragma unroll
                    for (int n = 0; n < 2; ++n) acc[a][b][m][n] = (f32x4){0.f, 0.f, 0.f, 0.f};
        cur = nxt; cA = nA; cB = nB; ++ui;
        if constexpr (ALIGN_EPI) { if (wr == 1) PG8_BAR; }
    }
    PG8_WAIT_V(0);
    if constexpr (!ALIGN_EPI) { if (wr == 0) PG8_BAR; }
    PG8_BAR;
    if constexpr (Epi::AFTER_DRAIN) { E.fused(acc, cur, wr, wc, fr, fq, lds, wid, lane); S.done(cur); }
#undef PG8_SA
#undef PG8_SB
#undef PG8_STAGE
#undef PG8_LDA
#undef PG8_LDB
#undef PG8_MMA
#undef PG8_WAIT_V
#undef PG8_WAIT_L
#undef PG8_BAR
#undef PG8_SCHED
}
}

#define LAS __attribute__((address_space(3)))
typedef unsigned short bf16;
typedef short bf16x8 __attribute__((ext_vector_type(8)));
typedef float f32x4 __attribute__((ext_vector_type(4)));
typedef float f32x16 __attribute__((ext_vector_type(16)));
typedef unsigned v4u __attribute__((ext_vector_type(4)));
typedef unsigned v2u __attribute__((ext_vector_type(2)));
using pg8::pkbf; using pg8::bflo; using pg8::bfhi;

constexpr int NWAVES = 8;
constexpr int DM = 2048, NB = 8, SEQ = 2048, DEPTH = 2, DBT = 128, DSQ = 4;
constexpr int MP = NB * SEQ, MS = DBT * DSQ, M = MP + MS;
constexpr int DG = 512, DIN = 3328, DFF = 8192, MEMT = 256, MEMROWS = NB * MEMT;
constexpr int C_U = 0, C_HC = 512, C_GB = 1024, C_GC = 1536, C_Q = 2048, C_K = 2560, C_V = 2688, C_QM = 2816;
constexpr int MC_POOL = 0, MC_CONV = 512, MC_SWA = 1024, MC_MEM = 1536;
constexpr float RMS_EPS = 1e-6f, LOG2E = 1.4426950408889634f;
constexpr size_t O_Y = 0;
constexpr size_t O_POOL_P = (size_t)M * DM;
constexpr size_t O_POOL_S = O_POOL_P + (size_t)DEPTH * NB * 15 * DG;
constexpr size_t O_CONV_P = O_POOL_S + (size_t)DEPTH * DBT * 15 * DG;
constexpr size_t O_CONV_S = O_CONV_P + (size_t)DEPTH * NB * 2 * DG;
constexpr size_t O_K_P = O_CONV_S + (size_t)DEPTH * DBT * 2 * DG;
constexpr size_t O_K_S = O_K_P + (size_t)DEPTH * NB * 128 * 128;
constexpr size_t O_V_P = O_K_S + (size_t)DEPTH * DBT * 128 * 128;
constexpr size_t O_V_S = O_V_P + (size_t)DEPTH * NB * 128 * 128;
constexpr size_t O_MK = O_V_S + (size_t)DEPTH * DBT * 128 * 128;
constexpr size_t O_MV = O_MK + (size_t)DEPTH * MEMROWS * DG;
constexpr size_t O_END = O_MV + (size_t)DEPTH * MEMROWS * DG;
static_assert(O_END == 50077696, "d_out size");
constexpr size_t MiB = 1u << 20;
constexpr size_t WS_F32 = 1 * MiB;
constexpr size_t WS_W = 8 * MiB;
constexpr size_t W_IN = 0, W_OUT = W_IN + (size_t)DIN * DM * 2, W_UP = W_OUT + (size_t)DM * DM * 2, W_DN = W_UP + (size_t)DFF * DM * 2, W_MKV = W_DN + (size_t)DM * DFF * 2,
                 W_POOL = W_MKV + (size_t)1024 * DM * 2, W_LAYER = W_POOL + (size_t)4 * 128 * 128 * 2;
static_assert(WS_W + 2 * W_LAYER <= 188 * MiB, "weights");
constexpr size_t WS_XB = 188 * MiB, WS_MIX = 254 * MiB, WS_MEMX = 320 * MiB, WS_MEMKV = 328 * MiB, WS_PROJ = 336 * MiB, WS_MIXCAT = 444 * MiB, WS_HID = 336 * MiB, WS_PART = 600 * MiB, WS_END = 664 * MiB;
static_assert((size_t)M * DM * 2 <= 66 * MiB && WS_PROJ + (size_t)M * DIN * 2 <= WS_MIXCAT && WS_MIXCAT + (size_t)M * DM * 2 <= WS_END && WS_HID + (size_t)M * DFF * 2 <= WS_PART, "ws map");
constexpr int F_RSTDA = 0, F_RSTDB = M, F_RSTDM = 2 * M, F_SSMIX = 2 * M + MEMROWS, F_SSFF = F_SSMIX + 2 * M, F_END = F_SSFF + 2 * M;
static_assert((size_t)F_END * 4 <= 7 * MiB, "f32 arrays");
constexpr int LDS_BYTES = 147456;

struct Args { const float* in[23]; float* out; unsigned char* ws; };
enum { I_XP = 0, I_XS, I_MEMP, I_SPOOL, I_SCONV, I_CK, I_CV, I_CMK, I_CMV, I_GPRE, I_WIN, I_WPOOL, I_PSCALE, I_CONVW, I_SINKS, I_GMEM, I_WMKV, I_WOUT, I_GPOST, I_GMLPPRE, I_WUP, I_WDN, I_GMLPPOST };

struct Frame {
    LAS unsigned char* lds;
    int G;
    Args a;
};
#define F_in a.in
#define F_out a.out
__device__ __forceinline__ bf16* XB_(const Frame& F) { return (bf16*)(F.a.ws + WS_XB); }
__device__ __forceinline__ bf16* MIXCAT_(const Frame& F) { return (bf16*)(F.a.ws + WS_MIXCAT); }
__device__ __forceinline__ bf16* MIX_(const Frame& F) { return (bf16*)(F.a.ws + WS_MIX); }
__device__ __forceinline__ bf16* MEMX_(const Frame& F) { return (bf16*)(F.a.ws + WS_MEMX); }
__device__ __forceinline__ bf16* MEMKV_(const Frame& F) { return (bf16*)(F.a.ws + WS_MEMKV); }
__device__ __forceinline__ bf16* PROJ_(const Frame& F) { return (bf16*)(F.a.ws + WS_PROJ); }
__device__ __forceinline__ bf16* HID_(const Frame& F) { return (bf16*)(F.a.ws + WS_HID); }
__device__ __forceinline__ float* PART_(const Frame& F) { return (float*)(F.a.ws + WS_PART); }
__device__ __forceinline__ float* F32A_(const Frame& F) { return (float*)(F.a.ws + WS_F32); }
__device__ __forceinline__ bf16* wptr(const Frame& F, int l, size_t off) { return (bf16*)(F.a.ws + WS_W + (size_t)l * W_LAYER + off); }
__device__ __forceinline__ float dpp_add(float v, const int ctrl_sel) {
    const int x = __builtin_bit_cast(int, v); int y;
    switch (ctrl_sel) { case 0: y = __builtin_amdgcn_mov_dpp(x, 0xB1, 0xF, 0xF, true); break;
                        case 1: y = __builtin_amdgcn_mov_dpp(x, 0x4E, 0xF, 0xF, true); break;
                        case 2: y = __builtin_amdgcn_mov_dpp(x, 0x141, 0xF, 0xF, true); break;
                        default: y = __builtin_amdgcn_mov_dpp(x, 0x140, 0xF, 0xF, true); break; }
    return v + __builtin_bit_cast(float, y);
}
__device__ __forceinline__ float wave_sum(float v) {
    v = dpp_add(v, 0); v = dpp_add(v, 1); v = dpp_add(v, 2); v = dpp_add(v, 3);
    const int x = __builtin_bit_cast(int, v);
    const float r0 = __builtin_bit_cast(float, __builtin_amdgcn_readlane(x, 0)), r1 = __builtin_bit_cast(float, __builtin_amdgcn_readlane(x, 16)),
                r2 = __builtin_bit_cast(float, __builtin_amdgcn_readlane(x, 32)), r3 = __builtin_bit_cast(float, __builtin_amdgcn_readlane(x, 48));
    return (r0 + r1) + (r2 + r3);
}
#define LDS_WAIT() asm volatile("s_waitcnt lgkmcnt(0)" ::: "memory")
#define PHASE_IDS int tid_ = threadIdx.x; asm volatile("" : "+v"(tid_)); const int tid = tid_, lane = tid & 63, wave = __builtin_amdgcn_readfirstlane(tid >> 6); (void)lane; (void)wave

__device__ __forceinline__ void xpose_item(const float* W, int K, int N, bf16* WT, const float* rg, const float* cgn, LAS float* scr, int item, int lane) {
    const int nblk = N / 32, kb = item / nblk, nb = item % nblk, k0 = 64 * kb, n0 = 32 * nb;
    const float cgv = cgn ? cgn[n0 + (lane & 31)] : 1.f;
#pragma unroll 8
    for (int i = 0; i < 32; ++i) { const int kk = 2 * i + (lane >> 5); float v = W[(size_t)(k0 + kk) * N + n0 + (lane & 31)]; const float g = rg ? rg[k0 + kk] : 1.f; scr[kk * 33 + (lane & 31)] = v * g * cgv; }
    LDS_WAIT(); asm volatile("" ::: "memory");
    const int c = lane & 7;
#pragma unroll
    for (int j = 0; j < 4; ++j) { const int n = (lane >> 3) + 8 * j; const LAS float* s = scr + (8 * c) * 33 + n;
        v4u o; o.x = pkbf(s[0 * 33], s[1 * 33]); o.y = pkbf(s[2 * 33], s[3 * 33]); o.z = pkbf(s[4 * 33], s[5 * 33]); o.w = pkbf(s[6 * 33], s[7 * 33]);
        *(v4u*)(WT + (size_t)(n0 + n) * K + k0 + 8 * c) = o; }
    LDS_WAIT(); asm volatile("" ::: "memory");
}
__device__ __forceinline__ void row_to_bf16(const float* xrow, bf16* orow, float* rstd_out, int lane) {
    const f32x4* xr = (const f32x4*)xrow + lane; float s = 0.f; v2u* o8 = (v2u*)orow + lane;
#pragma unroll
    for (int j = 0; j < 8; ++j) { const f32x4 v = xr[64 * j]; s += (v.x * v.x + v.y * v.y) + (v.z * v.z + v.w * v.w); v2u w; w.x = pkbf(v.x, v.y); w.y = pkbf(v.z, v.w); o8[64 * j] = w; }
    s = wave_sum(s);
    if (lane == 0) *rstd_out = 1.0f / sqrtf(s * (1.f / DM) + RMS_EPS);
}
__device__ __forceinline__ void p0_prologue(Frame& F) {
    PHASE_IDS;
    LAS float* scr = (LAS float*)(F.lds + wave * 16384);
    const int gw = blockIdx.x * NWAVES + wave, NGW = F.G * NWAVES;
    constexpr int IT_IN = (DM / 64) * (DIN / 32), IT_OUT = (DM / 64) * (DM / 32), IT_UP = (DM / 64) * (DFF / 32), IT_DN = (DFF / 64) * (DM / 32), IT_MKV = (DM / 64) * (1024 / 32), IT_POOL = 4 * 2 * 4;
    constexpr int IT_LAYER = IT_IN + IT_OUT + IT_UP + IT_DN + IT_MKV + IT_POOL;
    for (int it = gw; it < 2 * IT_LAYER; it += NGW) {
        const int l = it / IT_LAYER; int r = it % IT_LAYER;
        if (r < IT_IN) { xpose_item(F.a.in[I_WIN] + (size_t)l * DM * DIN, DM, DIN, wptr(F, l, W_IN), F.a.in[I_GPRE] + l * DM, nullptr, scr, r, lane); continue; } r -= IT_IN;
        if (r < IT_OUT) { xpose_item(F.a.in[I_WOUT] + (size_t)l * DM * DM, DM, DM, wptr(F, l, W_OUT), nullptr, nullptr, scr, r, lane); continue; } r -= IT_OUT;
        if (r < IT_UP) { xpose_item(F.a.in[I_WUP] + (size_t)l * DM * DFF, DM, DFF, wptr(F, l, W_UP), F.a.in[I_GMLPPRE] + l * DM, nullptr, scr, r, lane); continue; } r -= IT_UP;
        if (r < IT_DN) { xpose_item(F.a.in[I_WDN] + (size_t)l * DFF * DM, DFF, DM, wptr(F, l, W_DN), nullptr, nullptr, scr, r, lane); continue; } r -= IT_DN;
        if (r < IT_MKV) { xpose_item(F.a.in[I_WMKV] + (size_t)l * DM * 1024, DM, 1024, wptr(F, l, W_MKV), F.a.in[I_GMEM] + l * DM, nullptr, scr, r, lane); continue; } r -= IT_MKV;
        { const int g = r / 8, ri = r % 8; xpose_item(F.a.in[I_WPOOL] + (size_t)(l * 4 + g) * 128 * 128, 128, 128, wptr(F, l, W_POOL) + (size_t)g * 128 * 128, nullptr, F.a.in[I_PSCALE] + l * DG + g * 128, scr, ri, lane); }
    }
    for (int m = gw; m < M + MEMROWS; m += NGW) {
        if (m < MP) row_to_bf16(F.a.in[I_XP] + (size_t)m * DM, XB_(F) + (size_t)m * DM, F32A_(F) + F_RSTDA + m, lane);
        else if (m < M) row_to_bf16(F.a.in[I_XS] + (size_t)(m - MP) * DM, XB_(F) + (size_t)m * DM, F32A_(F) + F_RSTDA + m, lane);
        else row_to_bf16(F.a.in[I_MEMP] + (size_t)(m - M) * DM, MEMX_(F) + (size_t)(m - M) * DM, F32A_(F) + F_RSTDM + (m - M), lane);
    }
}

template <int D, bool MASK>
__device__ __forceinline__ void attn_sub(LAS const unsigned char* Kl, LAS const unsigned char* VTl, const bf16* qrow, bf16* orow, float m0, float l0, int lo, int hi, int t_lo, int t_hi, float scale2, int lane) {
    constexpr int KS = D * 2 + 16, VS = 528;
    const int r = lane & 31, h = lane >> 5;
    bf16x8 qf[D / 16];
#pragma unroll
    for (int d0 = 0; d0 < D / 16; ++d0) { if (qrow) qf[d0] = *(const bf16x8*)(qrow + d0 * 16 + 8 * h); else qf[d0] = (bf16x8){0, 0, 0, 0, 0, 0, 0, 0}; }
    f32x16 o[D / 32];
#pragma unroll
    for (int b = 0; b < D / 32; ++b)
#pragma unroll
        for (int i = 0; i < 16; ++i) o[b][i] = 0.f;
    float m = m0, l = (h == 0) ? l0 : 0.f;
    for (int t = t_lo; t <= t_hi; ++t) {
        f32x16 s;
#pragma unroll
        for (int i = 0; i < 16; ++i) s[i] = 0.f;
        LAS const unsigned char* kp = Kl + (t * 32 + r) * KS + h * 16;
#pragma unroll
        for (int d0 = 0; d0 < D / 16; ++d0) { const bf16x8 kf = *(LAS const bf16x8*)(kp + d0 * 32); s = __builtin_amdgcn_mfma_f32_32x32x16_bf16(kf, qf[d0], s, 0, 0, 0); }
        float mx = -INFINITY;
#pragma unroll
        for (int i = 0; i < 16; ++i) { const int key = t * 32 + (i & 3) + 8 * (i >> 2) + 4 * h; float v = s[i] * scale2; if (MASK) { if (!(key > lo && key <= hi)) v = -INFINITY; } s[i] = v; mx = fmaxf(mx, v); }
        mx = fmaxf(mx, __shfl_xor(mx, 32));
        const float mn = fmaxf(m, mx), alpha = __builtin_amdgcn_exp2f(m - mn);
        m = mn;
        float rs = 0.f;
#pragma unroll
        for (int i = 0; i < 16; ++i) { s[i] = __builtin_amdgcn_exp2f(s[i] - mn); rs += s[i]; }
        l = l * alpha + rs;
#pragma unroll
        for (int b = 0; b < D / 32; ++b)
#pragma unroll
            for (int i = 0; i < 16; ++i) o[b][i] *= alpha;
        v4u p0, p1;
        p0.x = pkbf(s[0], s[1]); p0.y = pkbf(s[2], s[3]); p0.z = pkbf(s[4], s[5]); p0.w = pkbf(s[6], s[7]);
        p1.x = pkbf(s[8], s[9]); p1.y = pkbf(s[10], s[11]); p1.z = pkbf(s[12], s[13]); p1.w = pkbf(s[14], s[15]);
        const bf16x8 pb0 = __builtin_bit_cast(bf16x8, p0), pb1 = __builtin_bit_cast(bf16x8, p1);
#pragma unroll
        for (int b = 0; b < D / 32; ++b) {
            LAS const unsigned char* vp = VTl + (b * 32 + r) * VS + (t * 32 + 4 * h) * 2;
            const v2u a0 = *(LAS const v2u*)(vp), a1 = *(LAS const v2u*)(vp + 16), a2 = *(LAS const v2u*)(vp + 32), a3 = *(LAS const v2u*)(vp + 48);
            const v4u f0 = {a0.x, a0.y, a1.x, a1.y}, f1 = {a2.x, a2.y, a3.x, a3.y};
            o[b] = __builtin_amdgcn_mfma_f32_32x32x16_bf16(__builtin_bit_cast(bf16x8, f0), pb0, o[b], 0, 0, 0);
            o[b] = __builtin_amdgcn_mfma_f32_32x32x16_bf16(__builtin_bit_cast(bf16x8, f1), pb1, o[b], 0, 0, 0);
        }
    }
    l += __shfl_xor(l, 32);
    const float inv = 1.0f / l;
    if (orow) {
#pragma unroll
        for (int b = 0; b < D / 32; ++b)
#pragma unroll
            for (int g4 = 0; g4 < 4; ++g4) { v2u w; w.x = pkbf(o[b][4 * g4] * inv, o[b][4 * g4 + 1] * inv); w.y = pkbf(o[b][4 * g4 + 2] * inv, o[b][4 * g4 + 3] * inv);
                *(v2u*)(orow + b * 32 + 8 * g4 + 4 * h) = w; }
    }
}
template <int D>
__device__ __forceinline__ void put_kv(LAS unsigned char* Kl, LAS unsigned char* VTl, int key, int ch, v4u kv, v4u vv) {
    constexpr int KS = D * 2 + 16, VS = 528;
    *(LAS v4u*)(Kl + key * KS + ch * 16) = kv;
    LAS unsigned char* vp = VTl + (ch * 8) * VS + key * 2;
    *(LAS unsigned short*)(vp + 0 * VS) = (unsigned short)(vv.x & 0xffffu); *(LAS unsigned short*)(vp + 1 * VS) = (unsigned short)(vv.x >> 16);
    *(LAS unsigned short*)(vp + 2 * VS) = (unsigned short)(vv.y & 0xffffu); *(LAS unsigned short*)(vp + 3 * VS) = (unsigned short)(vv.y >> 16);
    *(LAS unsigned short*)(vp + 4 * VS) = (unsigned short)(vv.z & 0xffffu); *(LAS unsigned short*)(vp + 5 * VS) = (unsigned short)(vv.z >> 16);
    *(LAS unsigned short*)(vp + 6 * VS) = (unsigned short)(vv.w & 0xffffu); *(LAS unsigned short*)(vp + 7 * VS) = (unsigned short)(vv.w >> 16);
}
__device__ __forceinline__ v4u cvt8(const float* p) { const f32x4 a = *(const f32x4*)p, b = *(const f32x4*)(p + 4); v4u w; w.x = pkbf(a.x, a.y); w.y = pkbf(a.z, a.w); w.z = pkbf(b.x, b.y); w.w = pkbf(b.z, b.w); return w; }

__device__ __forceinline__ void swa_prompt_unit(Frame& F, int l, int unit) {
    PHASE_IDS;
    constexpr int D = 64, KS = D * 2 + 16;
    const int b = unit >> 5, kvh = (unit >> 4) & 1, n = unit & 15;
    LAS unsigned char* Kl = F.lds; LAS unsigned char* VTl = F.lds + 256 * KS;
    const int row0 = b * SEQ + (n - 1) * 128;
    for (int c = tid; c < 256 * 8; c += 512) { const int key = c >> 3, ch = c & 7; v4u kv = {0u, 0u, 0u, 0u}, vv = {0u, 0u, 0u, 0u};
        if (!(n == 0 && key < 128)) { const bf16* rp = PROJ_(F) + (size_t)(row0 + key) * DIN; kv = *(const v4u*)(rp + C_K + kvh * 64 + ch * 8); vv = *(const v4u*)(rp + C_V + kvh * 64 + ch * 8); }
        put_kv<D>(Kl, VTl, key, ch, kv, vv); }
    __syncthreads();
    const int g = wave >> 1, r = lane & 31;
    const float sink2 = F.a.in[I_SINKS][l * 8 + kvh * 4 + g] * LOG2E;
    for (int sb = 0; sb < 2; ++sb) {
        const int i0 = (wave & 1) * 64 + sb * 32, i = i0 + r; const size_t row = (size_t)b * SEQ + n * 128 + i;
        int t_lo = i0 >> 5; if (n == 0 && t_lo < 4) t_lo = 4;
        const int lo = (n == 0 && i < 127) ? 127 : i;
        attn_sub<D, true>(Kl, VTl, PROJ_(F) + row * DIN + C_Q + kvh * 256 + g * 64, MIXCAT_(F) + row * DM + MC_SWA + kvh * 256 + g * 64, sink2, 1.0f, lo, i + 128, t_lo, (i0 >> 5) + 4, 0.125f * LOG2E, lane);
    }
    __syncthreads();
}
__device__ __forceinline__ void swa_sample_unit(Frame& F, int l, int unit) {
    PHASE_IDS;
    constexpr int D = 64, KS = D * 2 + 16;
    const int b = unit >> 1, kvh = unit & 1;
    LAS unsigned char* Kl = F.lds; LAS unsigned char* VTl = F.lds + 256 * KS;
    for (int c = tid; c < 160 * 8; c += 512) { const int key = c >> 3, ch = c & 7; v4u kv = {0u, 0u, 0u, 0u}, vv = {0u, 0u, 0u, 0u};
        if (key < 128) { const size_t ci = ((size_t)(l * DBT + b) * 128 + key) * 128 + kvh * 64 + ch * 8; kv = cvt8(F.a.in[I_CK] + ci); vv = cvt8(F.a.in[I_CV] + ci); }
        else if (key < 132) { const bf16* rp = PROJ_(F) + (size_t)(MP + b * 4 + key - 128) * DIN; kv = *(const v4u*)(rp + C_K + kvh * 64 + ch * 8); vv = *(const v4u*)(rp + C_V + kvh * 64 + ch * 8); }
        put_kv<D>(Kl, VTl, key, ch, kv, vv); }
    __syncthreads();
    if (wave == 0) {
        const int r = lane & 31, i = (r >> 2) & 3, g = r & 3; const bool valid = r < 16; const size_t row = (size_t)MP + b * 4 + i;
        const float sink2 = F.a.in[I_SINKS][l * 8 + kvh * 4 + g] * LOG2E;
        attn_sub<D, true>(Kl, VTl, valid ? PROJ_(F) + row * DIN + C_Q + kvh * 256 + g * 64 : nullptr, valid ? MIXCAT_(F) + row * DM + MC_SWA + kvh * 256 + g * 64 : nullptr, sink2, 1.0f, i, i + 128, 0, 4, 0.125f * LOG2E, lane);
    }
    __syncthreads();
}
__device__ __forceinline__ void mem_prompt_unit(Frame& F, int l, int unit) {
    PHASE_IDS;
    constexpr int D = 128, KS = D * 2 + 16;
    const int b = unit >> 5, hh = (unit >> 3) & 3, qt = unit & 7;
    LAS unsigned char* Kl = F.lds; LAS unsigned char* VTl = F.lds + 256 * KS;
    const bf16* kvb = MEMKV_(F) + (size_t)l * MEMROWS * 1024 + (size_t)b * MEMT * 1024 + hh * 128;
    for (int c = tid; c < 256 * 16; c += 512) { const int key = c >> 4, ch = c & 15; const bf16* rp = kvb + (size_t)key * 1024 + ch * 8;
        put_kv<D>(Kl, VTl, key, ch, *(const v4u*)rp, *(const v4u*)(rp + 512)); }
    __syncthreads();
    { const int r = lane & 31; const size_t row = (size_t)b * SEQ + qt * 256 + wave * 32 + r;
      attn_sub<D, false>(Kl, VTl, PROJ_(F) + row * DIN + C_QM + hh * 128, MIXCAT_(F) + row * DM + MC_MEM + hh * 128, -1e30f, 0.f, -1, 255, 0, 7, 0.08838834764831845f * LOG2E, lane); }
    __syncthreads();
}
__device__ __forceinline__ void mem_sample_unit(Frame& F, int l, int unit) {
    PHASE_IDS;
    constexpr int D = 128, KS = D * 2 + 16;
    const int b = unit >> 2, hh = unit & 3;
    LAS unsigned char* Kl = F.lds; LAS unsigned char* VTl = F.lds + 256 * KS;
    const size_t cb = ((size_t)(l * DBT + b) * MEMT) * 512 + hh * 128;
    for (int c = tid; c < 256 * 16; c += 512) { const int key = c >> 4, ch = c & 15; const size_t ci = cb + (size_t)key * 512 + ch * 8;
        put_kv<D>(Kl, VTl, key, ch, cvt8(F.a.in[I_CMK] + ci), cvt8(F.a.in[I_CMV] + ci)); }
    __syncthreads();
    if (wave == 0) { const int r = lane & 31; const bool valid = r < 4; const size_t row = (size_t)MP + b * 4 + (r & 3);
      attn_sub<D, false>(Kl, VTl, valid ? PROJ_(F) + row * DIN + C_QM + hh * 128 : nullptr, valid ? MIXCAT_(F) + row * DM + MC_MEM + hh * 128 : nullptr, -1e30f, 0.f, -1, 255, 0, 7, 0.08838834764831845f * LOG2E, lane); }
    __syncthreads();
}
__device__ __forceinline__ void poolconv_unit(Frame& F, int l, int unit) {
    PHASE_IDS;
    const int tok0 = unit * 64;
    {
        const int sub = wave >> 2, g = wave & 3, W = 2 << g, t0 = tok0 + sub * 32;
        LAS unsigned char* dl = F.lds + wave * (32 * 272);
        const int c = g * 128 + lane * 2;
        const bool prompt = t0 < MP;
        for (int tt = 0; tt < 32; ++tt) {
            const int row = t0 + tt; float s0 = 0.f, s1 = 0.f, u0, u1, cnt;
            const unsigned uw = *(const unsigned*)(PROJ_(F) + (size_t)row * DIN + C_U + c); u0 = bflo(uw); u1 = bfhi(uw);
            if (prompt) { const int pos = row & (SEQ - 1); const int nw = (pos + 1 < W) ? pos + 1 : W; cnt = (float)nw;
                for (int i = 0; i < nw; ++i) { const unsigned w = *(const unsigned*)(PROJ_(F) + (size_t)(row - i) * DIN + C_U + c); s0 += bflo(w); s1 += bfhi(w); } }
            else { const int sb = (row - MP) >> 2, i4 = (row - MP) & 3; cnt = (float)W;
                for (int i = 0; i < W; ++i) { const int e = 15 + i4 - i;
                    if (e >= 15) { const unsigned w = *(const unsigned*)(PROJ_(F) + (size_t)(MP + sb * 4 + e - 15) * DIN + C_U + c); s0 += bflo(w); s1 += bfhi(w); }
                    else { const float* sp = F.a.in[I_SPOOL] + ((size_t)(l * DBT + sb) * 15 + e) * DG + c; s0 += sp[0]; s1 += sp[1]; } } }
            *(LAS unsigned*)(dl + tt * 272 + lane * 4) = pkbf(s0 / cnt - u0, s1 / cnt - u1);
        }
        LDS_WAIT(); asm volatile("" ::: "memory");
        const int r = lane & 31, h = lane >> 5;
        bf16x8 bfr[8];
#pragma unroll
        for (int ks = 0; ks < 8; ++ks) bfr[ks] = *(LAS const bf16x8*)(dl + r * 272 + (ks * 16 + 8 * h) * 2);
        const bf16* wp = wptr(F, l, W_POOL) + (size_t)g * 128 * 128;
        bf16* orow = MIXCAT_(F) + (size_t)(t0 + r) * DM + MC_POOL + g * 128;
#pragma unroll
        for (int eb = 0; eb < 4; ++eb) {
            f32x16 acc;
#pragma unroll
            for (int i = 0; i < 16; ++i) acc[i] = 0.f;
#pragma unroll
            for (int ks = 0; ks < 8; ++ks) { const bf16x8 af = *(const bf16x8*)(wp + (size_t)(eb * 32 + r) * 128 + ks * 16 + 8 * h); acc = __builtin_amdgcn_mfma_f32_32x32x16_bf16(af, bfr[ks], acc, 0, 0, 0); }
#pragma unroll
            for (int g4 = 0; g4 < 4; ++g4) { v2u w; w.x = pkbf(acc[4 * g4], acc[4 * g4 + 1]); w.y = pkbf(acc[4 * g4 + 2], acc[4 * g4 + 3]); *(v2u*)(orow + eb * 32 + 8 * g4 + 4 * h) = w; }
        }
    }
    {
        const float* cw = F.a.in[I_CONVW] + (size_t)l * 3 * DG;
        for (int it = tid; it < 64 * 64; it += 512) {
            const int tt = it >> 6, c = (it & 63) * 8, row = tok0 + tt;
            float v[3][8];
#pragma unroll
            for (int k = 0; k < 3; ++k) {
                const int back = 2 - k; bool zero = false; const float* st = nullptr; int prow = row - back;
                if (row < MP) { if ((row & (SEQ - 1)) < back) zero = true; }
                else { const int sb = (row - MP) >> 2, i4 = (row - MP) & 3, e = 2 + i4 - back; if (e < 2) st = F.a.in[I_SCONV] + ((size_t)(l * DBT + sb) * 2 + e) * DG + c; else prow = MP + sb * 4 + e - 2; }
                if (zero) {
#pragma unroll
                    for (int j = 0; j < 8; ++j) v[k][j] = 0.f; }
                else if (st) { const f32x4 a = *(const f32x4*)st, bq = *(const f32x4*)(st + 4); v[k][0] = a.x; v[k][1] = a.y; v[k][2] = a.z; v[k][3] = a.w; v[k][4] = bq.x; v[k][5] = bq.y; v[k][6] = bq.z; v[k][7] = bq.w; }
                else { const bf16* rp = PROJ_(F) + (size_t)prow * DIN + c; const v4u hcv = *(const v4u*)(rp + C_HC), gcv = *(const v4u*)(rp + C_GC);
                    v[k][0] = bflo(hcv.x) * bflo(gcv.x); v[k][1] = bfhi(hcv.x) * bfhi(gcv.x); v[k][2] = bflo(hcv.y) * bflo(gcv.y); v[k][3] = bfhi(hcv.y) * bfhi(gcv.y);
                    v[k][4] = bflo(hcv.z) * bflo(gcv.z); v[k][5] = bfhi(hcv.z) * bfhi(gcv.z); v[k][6] = bflo(hcv.w) * bflo(gcv.w); v[k][7] = bfhi(hcv.w) * bfhi(gcv.w); }
            }
            const v4u gbv = *(const v4u*)(PROJ_(F) + (size_t)row * DIN + C_GB + c);
            float gb[8] = {bflo(gbv.x), bfhi(gbv.x), bflo(gbv.y), bfhi(gbv.y), bflo(gbv.z), bfhi(gbv.z), bflo(gbv.w), bfhi(gbv.w)};
            float y[8];
#pragma unroll
            for (int j = 0; j < 8; ++j) y[j] = gb[j] * (cw[c + j] * v[0][j] + cw[DG + c + j] * v[1][j] + cw[2 * DG + c + j] * v[2][j]);
            v4u w; w.x = pkbf(y[0], y[1]); w.y = pkbf(y[2], y[3]); w.z = pkbf(y[4], y[5]); w.w = pkbf(y[6], y[7]);
            *(v4u*)(MIXCAT_(F) + (size_t)row * DM + MC_CONV + c) = w;
        }
    }
    __syncthreads();
}
__device__ __forceinline__ f32x4 bf4(const bf16* p) { const v2u w = *(const v2u*)p; return (f32x4){bflo(w.x), bfhi(w.x), bflo(w.y), bfhi(w.y)}; }
__device__ __forceinline__ f32x4 vrow4(const bf16* rp) { return bf4(rp + C_HC) * bf4(rp + C_GC); }
__device__ __forceinline__ void states_phase(Frame& F, int l) {
    PHASE_IDS;
    const int gt = blockIdx.x * 512 + tid, NT = F.G * 512;
    float* out = F.a.out; const bf16* P = PROJ_(F);
    for (int i = gt; i < NB * 15 * 128; i += NT) { const int c = (i & 127) * 4, j = (i >> 7) % 15, b = (i >> 7) / 15;
        *(f32x4*)(out + O_POOL_P + ((size_t)(l * NB + b) * 15 + j) * DG + c) = bf4(P + (size_t)(b * SEQ + SEQ - 15 + j) * DIN + C_U + c); }
    for (int i = gt; i < DBT * 15 * 128; i += NT) { const int c = (i & 127) * 4, j = (i >> 7) % 15, b = (i >> 7) / 15; f32x4 v;
        if (j < 11) v = *(const f32x4*)(F.a.in[I_SPOOL] + ((size_t)(l * DBT + b) * 15 + 4 + j) * DG + c); else v = bf4(P + (size_t)(MP + b * 4 + j - 11) * DIN + C_U + c);
        *(f32x4*)(out + O_POOL_S + ((size_t)(l * DBT + b) * 15 + j) * DG + c) = v; }
    for (int i = gt; i < NB * 2 * 128; i += NT) { const int c = (i & 127) * 4, j = (i >> 7) & 1, b = i >> 8;
        *(f32x4*)(out + O_CONV_P + ((size_t)(l * NB + b) * 2 + j) * DG + c) = vrow4(P + (size_t)(b * SEQ + SEQ - 2 + j) * DIN + c); }
    for (int i = gt; i < DBT * 2 * 128; i += NT) { const int c = (i & 127) * 4, j = (i >> 7) & 1, b = i >> 8;
        *(f32x4*)(out + O_CONV_S + ((size_t)(l * DBT + b) * 2 + j) * DG + c) = vrow4(P + (size_t)(MP + b * 4 + 2 + j) * DIN + c); }
    for (int i = gt; i < NB * 128 * 32; i += NT) { const int c = (i & 31) * 4, j = (i >> 5) & 127, b = i >> 12; const bf16* rp = P + (size_t)(b * SEQ + SEQ - 128 + j) * DIN + c; const size_t o = ((size_t)(l * NB + b) * 128 + j) * 128 + c;
        *(f32x4*)(out + O_K_P + o) = bf4(rp + C_K); *(f32x4*)(out + O_V_P + o) = bf4(rp + C_V); }
    for (int i = gt; i < DBT * 128 * 32; i += NT) { const int c = (i & 31) * 4, j = (i >> 5) & 127, b = i >> 12; const size_t o = ((size_t)(l * DBT + b) * 128 + j) * 128 + c; f32x4 kv, vv;
        if (j < 124) { const size_t ci = ((size_t)(l * DBT + b) * 128 + 4 + j) * 128 + c; kv = *(const f32x4*)(F.a.in[I_CK] + ci); vv = *(const f32x4*)(F.a.in[I_CV] + ci); }
        else { const bf16* rp = P + (size_t)(MP + b * 4 + j - 124) * DIN + c; kv = bf4(rp + C_K); vv = bf4(rp + C_V); }
        *(f32x4*)(out + O_K_S + o) = kv; *(f32x4*)(out + O_V_S + o) = vv; }
}
__device__ __forceinline__ void p2_mixers(Frame& F, int l) {
#ifndef SK_A
    for (int u = blockIdx.x; u < 256; u += F.G) swa_prompt_unit(F, l, u);
#endif
#ifndef SK_B
    for (int u = blockIdx.x; u < 256; u += F.G) mem_prompt_unit(F, l, u);
#endif
#ifndef SK_C
    for (int u = blockIdx.x; u < 256; u += F.G) swa_sample_unit(F, l, u);
#endif
#ifndef SK_D
    for (int u = blockIdx.x; u < 512; u += F.G) mem_sample_unit(F, l, u);
#endif
#ifndef SK_E
    for (int u = blockIdx.x; u < M / 64; u += F.G) poolconv_unit(F, l, u);
#endif
#ifndef SK_F
    states_phase(F, l);
#endif
}

__device__ __forceinline__ void rowwise_phase(Frame& F, bool first, int nsplit, const float* gain, float* rstd_out) {
    PHASE_IDS;
    const int gw = blockIdx.x * NWAVES + wave, NGW = F.G * NWAVES;
    for (int m = gw; m < M; m += NGW) {
        const float* xr = first ? (m < MP ? F.a.in[I_XP] + (size_t)m * DM : F.a.in[I_XS] + (size_t)(m - MP) * DM) : F.a.out + O_Y + (size_t)m * DM;
        float* yr = F.a.out + O_Y + (size_t)m * DM; bf16* xb = XB_(F) + (size_t)m * DM;
        f32x4 t[8]; float q = 0.f;
        if (m < MP) { const bf16* tr = MIX_(F) + (size_t)m * DM;
#pragma unroll
            for (int j = 0; j < 8; ++j) t[j] = bf4(tr + j * 256 + lane * 4); }
        else { const float* pr = PART_(F) + (size_t)(m - MP) * DM;
#pragma unroll
            for (int j = 0; j < 8; ++j) t[j] = (f32x4){0.f, 0.f, 0.f, 0.f};
#pragma unroll 1
            for (int p = 0; p < nsplit; ++p) {
#pragma unroll
                for (int j = 0; j < 8; ++j) t[j] += *(const f32x4*)(pr + (size_t)p * 512 * 2048 + j * 256 + lane * 4); } }
#pragma unroll
        for (int j = 0; j < 8; ++j) q += (t[j].x * t[j].x + t[j].y * t[j].y) + (t[j].z * t[j].z + t[j].w * t[j].w);
        q = wave_sum(q);
        const float rs = 1.0f / sqrtf(q * (1.f / DM) + RMS_EPS);
        float s = 0.f;
#pragma unroll
        for (int j = 0; j < 8; ++j) { const int c = j * 256 + lane * 4; const f32x4 x = *(const f32x4*)(xr + c), g = *(const f32x4*)(gain + c);
            t[j] = x + g * t[j] * rs; s += (t[j].x * t[j].x + t[j].y * t[j].y) + (t[j].z * t[j].z + t[j].w * t[j].w); }
        s = wave_sum(s);
#pragma unroll
        for (int j = 0; j < 8; ++j) { const int c = j * 256 + lane * 4; *(f32x4*)(yr + c) = t[j];
            if (rstd_out) { v2u w; w.x = pkbf(t[j].x, t[j].y); w.y = pkbf(t[j].z, t[j].w); *(v2u*)(xb + c) = w; } }
        if (rstd_out && lane == 0) rstd_out[m] = 1.0f / sqrtf(s * (1.f / DM) + RMS_EPS);
    }
}

#ifndef SK_G
#define GEMM_PHASE(EPI, g, S, E) pg8::gemm_phase<EPI, pg8::StaticOrder, true, true>(F.lds, g, S, E)
#else
#define GEMM_PHASE(EPI, g, S, E) do { (void)g; (void)S; (void)E; } while (0)
#endif
template <int l> __device__ __forceinline__ void layer_body(Frame& F, cg::grid_group& grid) {
    {
        pg8::Gemm g{XB_(F), wptr(F, l, W_IN), M, DIN, DM, DM}; pg8::StaticOrder S; S.init(M, DIN, F.G, (int)blockIdx.x);
        pg8::EpiRowScale<0> E{PROJ_(F), DIN, F32A_(F) + F_RSTDA};
        GEMM_PHASE(pg8::EpiRowScale<0>, g, S, E);
        pg8::Gemm g2{MEMX_(F), wptr(F, l, W_MKV), MEMROWS, 1024, DM, DM}; pg8::StaticOrder S2; S2.init(MEMROWS, 1024, F.G, F.G - 1 - (int)blockIdx.x);
        pg8::EpiMemKV E2{MEMKV_(F) + (size_t)l * MEMROWS * 1024, F.a.out + O_MK + (size_t)l * MEMROWS * DG, F.a.out + O_MV + (size_t)l * MEMROWS * DG, F32A_(F) + F_RSTDM};
        GEMM_PHASE(pg8::EpiMemKV, g2, S2, E2);
    }
    grid.sync();
    p2_mixers(F, l);
    grid.sync();
    {
        pg8::Gemm g{MIXCAT_(F), wptr(F, l, W_OUT), MP, DM, DM, DM}; pg8::StaticOrder S; S.init(MP, DM, F.G, (int)blockIdx.x);
        pg8::EpiStore E{MIX_(F), DM};
        GEMM_PHASE(pg8::EpiStore, g, S, E);
        pg8::Gemm g2{MIXCAT_(F), wptr(F, l, W_OUT), M, DM, DM / 8, DM}; pg8::SplitOrder S2{128, DM / 8, F.G, (int)blockIdx.x};
        pg8::EpiPartF32 E2{PART_(F), DM / 8};
        pg8::gemm_phase<pg8::EpiPartF32, pg8::SplitOrder, true, true>(F.lds, g2, S2, E2);
    }
    grid.sync();
    rowwise_phase(F, l == 0, 8, F.a.in[I_GPOST] + l * DM, F32A_(F) + F_RSTDB);
    grid.sync();
    {
        pg8::Gemm g{XB_(F), wptr(F, l, W_UP), M, DFF, DM, DM}; pg8::StaticOrder S; S.init(M, DFF, F.G, (int)blockIdx.x);
        pg8::EpiRowScale<1> E{HID_(F), DFF, F32A_(F) + F_RSTDB};
        GEMM_PHASE(pg8::EpiRowScale<1>, g, S, E);
    }
    grid.sync();
    {
        pg8::Gemm g{HID_(F), wptr(F, l, W_DN), MP, DM, DFF, DFF}; pg8::StaticOrder S; S.init(MP, DM, F.G, (int)blockIdx.x);
        pg8::EpiStore E{MIX_(F), DM};
        GEMM_PHASE(pg8::EpiStore, g, S, E);
        pg8::Gemm g2{HID_(F), wptr(F, l, W_DN), M, DM, DFF / 16, DFF}; pg8::SplitOrder S2{256, DFF / 16, F.G, (int)blockIdx.x};
        pg8::EpiPartF32 E2{PART_(F), DFF / 16};
        pg8::gemm_phase<pg8::EpiPartF32, pg8::SplitOrder, true, true>(F.lds, g2, S2, E2);
    }
    grid.sync();
    rowwise_phase(F, false, 16, F.a.in[I_GMLPPOST] + l * DM, (l + 1 < DEPTH) ? F32A_(F) + F_RSTDA : nullptr);
    if (l + 1 < DEPTH) grid.sync();
}
__global__ void __launch_bounds__(NWAVES * 64, 2) hymba_fwd(Args args) {
    extern __shared__ __attribute__((aligned(16))) unsigned char lds[];
    cg::grid_group grid = cg::this_grid();
    Frame F;
    F.lds = (LAS unsigned char*)lds;
    F.G = gridDim.x;
    F.a = args;
    p0_prologue(F);
    grid.sync();
    layer_body<0>(F, grid);
    layer_body<1>(F, grid);
}

extern "C" void kernel_launch(void* const* d_in, const int* in_sizes, int n_in, void* d_out, int out_size, void* d_ws, size_t ws_size, hipStream_t stream) {
    static int grid = 0;
    if (grid == 0) {
        if (n_in != 23 || in_sizes[0] != MP * DM || (size_t)out_size != O_END || ws_size < WS_END) { fprintf(stderr, "kernel_launch: unexpected shapes (n_in %d, in0 %d, out %d, ws %zu); nothing launched\n", n_in, n_in > 0 ? in_sizes[0] : -1, out_size, ws_size); grid = -1; return; }
        int dev = 0, cus = 0, per_cu = 0;
        if (hipGetDevice(&dev) != hipSuccess || hipDeviceGetAttribute(&cus, hipDeviceAttributeMultiprocessorCount, dev) != hipSuccess) { grid = -1; return; }
        if (hipFuncSetAttribute((const void*)hymba_fwd, hipFuncAttributeMaxDynamicSharedMemorySize, LDS_BYTES) != hipSuccess) { fprintf(stderr, "kernel_launch: hipFuncSetAttribute failed\n"); grid = -1; return; }
        if (hipOccupancyMaxActiveBlocksPerMultiprocessor(&per_cu, (const void*)hymba_fwd, NWAVES * 64, LDS_BYTES) != hipSuccess || per_cu < 1) { fprintf(stderr, "kernel_launch: occupancy query says %d blocks per CU\n", per_cu); per_cu = 1; }
        (void)hipGetLastError();
        grid = cus * per_cu;
    }
    if (grid < 0) return;
    Args a{};
    for (int i = 0; i < 23; ++i) a.in[i] = (const float*)d_in[i];
    a.out = (float*)d_out; a.ws = (unsigned char*)d_ws;
    void* kargs[] = {&a};
    const hipError_t e = hipLaunchCooperativeKernel((const void*)hymba_fwd, dim3(grid), dim3(NWAVES * 64), kargs, LDS_BYTES, stream);
    if (e != hipSuccess) fprintf(stderr, "kernel_launch: cooperative launch failed: %s (grid %d)\n", hipGetErrorString(e), grid);
}
```
